# Optimizing an MI355X kernel written in HIP

```python
import jax, jax.numpy as jnp
from jax import lax
import numpy as np

D_MODEL = 1024
BATCH = 8
SEQ = 2048
DEPTH = 1
DEC_BATCH = 128
DEC_SEQ = 4
PAST_LEN = 16384
PAGE_SIZE = 128

HEAD_DIM = 64
N_Q_HEADS = 8
N_KV_HEADS = 2
GQA_GROUP = N_Q_HEADS // N_KV_HEADS
ATTN_WIDTH = N_Q_HEADS * HEAD_DIM
KV_WIDTH = N_KV_HEADS * HEAD_DIM
CONV_WIDTH = D_MODEL - ATTN_WIDTH
CONV_K = 3
WINDOW = 128
BLOCK = 128
ROPE_THETA = 10000.0
D_FF = 4 * D_MODEL
PLE_DIM = 256
EPS = 1e-6
NEG = -1e30
IN_WIDTH = ATTN_WIDTH + 2 * KV_WIDTH + 3 * CONV_WIDTH
SPLITS = [ATTN_WIDTH, ATTN_WIDTH + KV_WIDTH, ATTN_WIDTH + 2 * KV_WIDTH,
          ATTN_WIDTH + 2 * KV_WIDTH + CONV_WIDTH, ATTN_WIDTH + 2 * KV_WIDTH + 2 * CONV_WIDTH]

kernel_name = 'hybrid_swa_sink_shortconv_step'


def rmsnorm(x, g):
    xf = x.astype(jnp.float32)
    y = xf * lax.rsqrt(jnp.mean(xf * xf, axis=-1, keepdims=True) + EPS)
    return (y * g.astype(jnp.float32)).astype(x.dtype)


def rope(x, pos):
    inv_freq = ROPE_THETA ** (-jnp.arange(0, HEAD_DIM, 2, dtype=jnp.float32) / HEAD_DIM)
    ang = pos.astype(jnp.float32)[:, None] * inv_freq[None, :]
    cos = jnp.cos(ang)[:, None, :]
    sin = jnp.sin(ang)[:, None, :]
    xf = x.astype(jnp.float32)
    x1, x2 = xf[..., : HEAD_DIM // 2], xf[..., HEAD_DIM // 2:]
    return jnp.concatenate([x1 * cos - x2 * sin, x2 * cos + x1 * sin], axis=-1).astype(x.dtype)


def sink_attention(q, k, v, mask, sinks):
    s = jnp.einsum('...qhgd,...khd->...hgqk', q, k).astype(jnp.float32) * (HEAD_DIM ** -0.5)
    s = jnp.where(mask, s, NEG)
    sink = sinks.astype(jnp.float32).reshape(N_KV_HEADS, GQA_GROUP)[:, :, None, None]
    m = jnp.maximum(jnp.max(s, axis=-1, keepdims=True), sink)
    e = jnp.exp(s - m)
    probs = e / (jnp.sum(e, axis=-1, keepdims=True) + jnp.exp(sink - m))
    return jnp.einsum('...hgqk,...khd->...qhgd', probs.astype(v.dtype), v)


def banded_window_attention(q, k, v, sinks):
    bn, s_len = q.shape[0], q.shape[1]
    nb = s_len // BLOCK
    qb = q.reshape(bn, nb, BLOCK, N_KV_HEADS, GQA_GROUP, HEAD_DIM)

    def with_prev(t):
        tb = t.reshape(bn, nb, BLOCK, N_KV_HEADS, HEAD_DIM)
        prev = jnp.concatenate([jnp.zeros_like(tb[:, :1]), tb[:, :-1]], axis=1)
        return jnp.concatenate([prev, tb], axis=2)

    kb, vb = with_prev(k), with_prev(v)
    qi = jnp.arange(BLOCK)[:, None]
    kj = jnp.arange(2 * BLOCK)[None, :]
    diff = qi + BLOCK - kj
    band = (diff >= 0) & (diff < WINDOW)
    real = (jnp.arange(nb)[:, None, None] > 0) | (kj >= BLOCK)[None]
    mask = (band[None] & real)[:, None, None]
    o = sink_attention(qb, kb, vb, mask, sinks)
    return o.reshape(bn, s_len, ATTN_WIDTH)


def cached_window_attention(q, k, v, past_k, past_v, sinks):
    bn, t_len = q.shape[0], q.shape[1]
    w = past_k.shape[1]
    kk = jnp.concatenate([past_k, k], axis=1)
    vv = jnp.concatenate([past_v, v], axis=1)
    qg = q.reshape(bn, t_len, N_KV_HEADS, GQA_GROUP, HEAD_DIM)
    diff = jnp.arange(t_len)[:, None] + w - jnp.arange(w + t_len)[None, :]
    mask = (diff >= 0) & (diff < WINDOW)
    o = sink_attention(qg, kk, vv, mask, sinks)
    return o.reshape(bn, t_len, ATTN_WIDTH), kk[:, t_len:], vv[:, t_len:]


def decoder_layer(x, p, pos, past_k, past_v, past_conv, g_mix_norm, w_in, g_q, g_k, sinks, conv_w,
                  g_attn_out, g_conv_out, w_o, g_mlp_norm, w_up, w_down, g_ple_norm, w_ple_gate, w_ple):
    bn, s_len, _ = x.shape
    h = rmsnorm(x, g_mix_norm)
    z = h @ w_in
    q, k, v, b_gate, c_gate, hc = jnp.split(z, SPLITS, axis=-1)
    q = rope(rmsnorm(q.reshape(bn, s_len, N_Q_HEADS, HEAD_DIM), g_q), pos)
    k = rope(rmsnorm(k.reshape(bn, s_len, N_KV_HEADS, HEAD_DIM), g_k), pos)
    v = v.reshape(bn, s_len, N_KV_HEADS, HEAD_DIM)
    u = c_gate * hc
    if past_k is None:
        o_attn = banded_window_attention(q, k, v, sinks)
        wbuf = min(WINDOW, s_len)
        new_k, new_v = k[:, s_len - wbuf:], v[:, s_len - wbuf:]
        u_full = jnp.pad(u, ((0, 0), (CONV_K - 1, 0), (0, 0)))
    else:
        o_attn, new_k, new_v = cached_window_attention(q, k, v, past_k, past_v, sinks)
        u_full = jnp.concatenate([past_conv.astype(u.dtype), u], axis=1)
    new_conv = u_full[:, u_full.shape[1] - (CONV_K - 1):]
    conv = conv_w[0] * u_full[:, 0:s_len]
    for j in range(1, CONV_K):
        conv = conv + conv_w[j] * u_full[:, j:j + s_len]
    o_conv = b_gate * conv
    mixed = jnp.concatenate([rmsnorm(o_attn, g_attn_out), rmsnorm(o_conv, g_conv_out)], axis=-1)
    x = x + mixed @ w_o
    hm = rmsnorm(x, g_mlp_norm)
    x = x + jnp.square(jax.nn.relu(hm @ w_up)) @ w_down
    gate = jax.nn.sigmoid(rmsnorm(x, g_ple_norm) @ w_ple_gate)
    x = x + gate * (p @ w_ple)
    return x, new_k, new_v, new_conv


def setup_inputs(seed: int = 0) -> dict:
    key = jax.random.key(seed)
    ks = jax.random.split(key, 24)
    f32 = jnp.float32

    def nrm(k, shape, scale=1.0):
        return jax.random.normal(k, shape, f32) * scale

    def gain(k, shape):
        return 1.0 + 0.05 * jax.random.normal(k, shape, f32)

    wbuf = min(WINDOW, PAST_LEN)
    return {
        'x_prompt': nrm(ks[0], (BATCH, SEQ, D_MODEL)),
        'x_sample': nrm(ks[1], (DEC_BATCH, DEC_SEQ, D_MODEL)),
        'p_prompt': nrm(ks[2], (DEPTH, BATCH, SEQ, PLE_DIM)),
        'p_sample': nrm(ks[3], (DEPTH, DEC_BATCH, DEC_SEQ, PLE_DIM)),
        'cache_k': nrm(ks[4], (DEPTH, DEC_BATCH, wbuf, N_KV_HEADS, HEAD_DIM)),
        'cache_v': nrm(ks[5], (DEPTH, DEC_BATCH, wbuf, N_KV_HEADS, HEAD_DIM)),
        'state_conv': nrm(ks[6], (DEPTH, DEC_BATCH, CONV_K - 1, CONV_WIDTH)),
        'g_mix_norm': gain(ks[7], (DEPTH, D_MODEL)),
        'w_in': nrm(ks[8], (DEPTH, D_MODEL, IN_WIDTH), D_MODEL ** -0.5),
        'g_q': gain(ks[9], (DEPTH, HEAD_DIM)),
        'g_k': gain(ks[10], (DEPTH, HEAD_DIM)),
        'sinks': nrm(ks[11], (DEPTH, N_Q_HEADS), 0.5),
        'conv_w': nrm(ks[12], (DEPTH, CONV_K, CONV_WIDTH), CONV_K ** -0.5),
        'g_attn_out': gain(ks[13], (DEPTH, ATTN_WIDTH)),
        'g_conv_out': gain(ks[14], (DEPTH, CONV_WIDTH)),
        'w_o': nrm(ks[15], (DEPTH, D_MODEL, D_MODEL), D_MODEL ** -0.5),
        'g_mlp_norm': gain(ks[16], (DEPTH, D_MODEL)),
        'w_up': nrm(ks[17], (DEPTH, D_MODEL, D_FF), D_MODEL ** -0.5),
        'w_down': nrm(ks[18], (DEPTH, D_FF, D_MODEL), D_FF ** -0.5),
        'g_ple_norm': gain(ks[19], (DEPTH, D_MODEL)),
        'w_ple_gate': nrm(ks[20], (DEPTH, D_MODEL, D_MODEL), D_MODEL ** -0.5),
        'w_ple': nrm(ks[21], (DEPTH, PLE_DIM, D_MODEL), PLE_DIM ** -0.5),
    }


def reference(x_prompt, x_sample, p_prompt, p_sample, cache_k, cache_v, state_conv,
              g_mix_norm, w_in, g_q, g_k, sinks, conv_w, g_attn_out, g_conv_out, w_o,
              g_mlp_norm, w_up, w_down, g_ple_norm, w_ple_gate, w_ple):
    pos_p = jnp.arange(x_prompt.shape[1], dtype=jnp.int32)
    pos_s = PAST_LEN + jnp.arange(x_sample.shape[1], dtype=jnp.int32)
    yp, ys = x_prompt, x_sample
    kp_l, vp_l, cp_l, ks_l, vs_l, cs_l = [], [], [], [], [], []
    for i in range(DEPTH):
        w = (g_mix_norm[i], w_in[i], g_q[i], g_k[i], sinks[i], conv_w[i], g_attn_out[i],
             g_conv_out[i], w_o[i], g_mlp_norm[i], w_up[i], w_down[i], g_ple_norm[i],
             w_ple_gate[i], w_ple[i])
        yp, kp, vp, cp = decoder_layer(yp, p_prompt[i], pos_p, None, None, None, *w)
        ys, ksn, vsn, csn = decoder_layer(ys, p_sample[i], pos_s, cache_k[i], cache_v[i],
                                          state_conv[i], *w)
        kp_l.append(kp); vp_l.append(vp); cp_l.append(cp)
        ks_l.append(ksn); vs_l.append(vsn); cs_l.append(csn)
    k_prompt = jnp.stack(kp_l); v_prompt = jnp.stack(vp_l); conv_prompt = jnp.stack(cp_l)
    k_sample = jnp.stack(ks_l); v_sample = jnp.stack(vs_l); conv_sample = jnp.stack(cs_l)
    return (yp, ys, k_prompt, v_prompt, conv_prompt, k_sample, v_sample, conv_sample)
```

```cpp
#include <hip/hip_runtime.h>
#include <hip/hip_cooperative_groups.h>
#include <cstdio>
#include <cstdint>
namespace cg = cooperative_groups;
__device__ __forceinline__ int opaque_tid() { int t = (int)threadIdx.x; asm volatile("" : "+v"(t)); return t; }
__device__ __forceinline__ int opaque_bid() { return (int)blockIdx.x; }
namespace pg8 {
#define PG8_LAS __attribute__((address_space(3)))
typedef unsigned short bf16_t;
typedef short bf16x8 __attribute__((ext_vector_type(8)));
typedef float f32x4 __attribute__((ext_vector_type(4)));
typedef unsigned u32x4 __attribute__((ext_vector_type(4)));
constexpr int BM = 256, BK = 64, HALF = 128, HTB = HALF * BK * 2  , STAGE_BYTES = 8 * HTB, NXCD = 8, WGM = 8;

__host__ __device__ __forceinline__ int lds_byte(int r, int c) { const int st = (r >> 4) * 2 + (c >> 5), rr = r & 15, cc = c & 31, ob = rr * 64 + cc * 2; return st * 1024 + (ob ^ (((ob >> 9) & 1) << 5)); }
__host__ __device__ __forceinline__ void stage_rc(int b, int& R, int& C) { const int st = b / 1024, sb = b % 1024, swz = sb ^ (((sb >> 9) & 1) << 5); R = (st >> 1) * 16 + swz / 64; C = (st & 1) * 32 + (swz % 64) / 2; }
__host__ __device__ __forceinline__ int perm32(int rho) { const int n = rho >> 4, i = rho & 15; return 8 * (i >> 2) + 4 * n + (i & 3); }

struct Unit { int pm, pn; };
struct Gemm { const bf16_t* A; const bf16_t* Bt; int M, N, K; };

struct StaticOrder {
    int nM, nN, nwg, G, c;
    __host__ __device__ void init(int M, int N, int G_, int c_) { nM = M / BM; nN = N / BM; nwg = nM * nN; G = G_; c = c_; }
    __host__ __device__ bool next(int i, Unit& u) const {
        const long L = (long)i * G + c; if (L >= nwg) return false;
        int wgid = (int)L; { const int q = nwg / NXCD, r = nwg % NXCD, xcd = wgid % NXCD, off = wgid / NXCD; wgid = (xcd < r ? xcd * (q + 1) : r * (q + 1) + (xcd - r) * q) + off; }
        const int nig = WGM * nN, gid = wgid / nig, fm = gid * WGM, gsz = (nM - fm) < WGM ? (nM - fm) : WGM;
        u.pm = fm + ((wgid % nig) % gsz); u.pn = (wgid % nig) / gsz; return true;
    }
    __device__ __forceinline__ void a_ready(const Unit&) const {}
    __device__ __forceinline__ void done(const Unit&) const {}
};

__device__ __forceinline__ unsigned cvt_pk_bf16(float lo, float hi) { unsigned r; asm volatile("v_cvt_pk_bf16_f32 %0, %1, %2" : "=v"(r) : "v"(lo), "v"(hi)); return r; }
typedef float f32x2 __attribute__((ext_vector_type(2)));
constexpr float RMS_EPS = 1e-6f;
__device__ __forceinline__ float rstd_from_ssp(const float* ssp, int row) {
    const f32x4* p = (const f32x4*)(ssp + (size_t)row * 16); const f32x4 s = (p[0] + p[1]) + (p[2] + p[3]);
    return rsqrtf(((s[0] + s[1]) + (s[2] + s[3])) * (1.0f / 1024.0f) + RMS_EPS);
}
__device__ __forceinline__ void unpack_bf16x8(const u32x4 w, f32x4& lo, f32x4& hi) {
    lo = (f32x4){__uint_as_float(w.x << 16), __uint_as_float(w.x & 0xffff0000u), __uint_as_float(w.y << 16), __uint_as_float(w.y & 0xffff0000u)};
    hi = (f32x4){__uint_as_float(w.z << 16), __uint_as_float(w.z & 0xffff0000u), __uint_as_float(w.w << 16), __uint_as_float(w.w & 0xffff0000u)};
}
template <int MODE> struct Epi {
    static constexpr bool PERM = true, AFTER_DRAIN = false;
    bf16_t* O; int ldo; const float* rs; const float* ssp;
    const float* base0; const float* base1; float* out; float* sspo; const bf16_t* pp;
    __device__ __forceinline__ void operator()(const f32x4 (&acc)[2][2][4][2], const Unit& u, int wr, int wc, int fr, int fq) const {
        const int row0 = u.pm * BM + wr * 64 + fr, col0 = u.pn * BM + wc * 32 + 8 * fq;
        float sc[2][4];
        if constexpr (MODE == 0) {
#pragma unroll
            for (int ai = 0; ai < 2; ++ai)
#pragma unroll
                for (int m = 0; m < 4; ++m) sc[ai][m] = rs ? rs[row0 + ai * HALF + m * 16] : 1.0f;
        } else if constexpr (MODE == 1 || MODE == 3) {
            f32x4 pz[2][4];
#pragma unroll
            for (int ai = 0; ai < 2; ++ai)
#pragma unroll
                for (int m = 0; m < 4; ++m) pz[ai][m] = *(const f32x4*)(ssp + (size_t)(row0 + ai * HALF + m * 16) * 16 + 4 * fq);
#pragma unroll
            for (int ai = 0; ai < 2; ++ai)
#pragma unroll
                for (int m = 0; m < 4; ++m) { float t = (pz[ai][m][0] + pz[ai][m][1]) + (pz[ai][m][2] + pz[ai][m][3]); t += __shfl_xor(t, 16); t += __shfl_xor(t, 32);
                    sc[ai][m] = rsqrtf(t * (1.0f / 1024.0f) + RMS_EPS); }
        }
        if constexpr (MODE == 0 || MODE == 1) {
#pragma unroll
            for (int ai = 0; ai < 2; ++ai)
#pragma unroll
                for (int m = 0; m < 4; ++m) {
                    bf16_t* rowp = O + (size_t)(row0 + ai * HALF + m * 16) * ldo + col0; const float s1 = sc[ai][m];
#pragma unroll
                    for (int bj = 0; bj < 2; ++bj) { f32x4 v0 = acc[ai][bj][m][0] * s1, v1 = acc[ai][bj][m][1] * s1;
                        if constexpr (MODE == 1) {
#pragma unroll
                            for (int e = 0; e < 4; ++e) { const float a = fmaxf(v0[e], 0.f), b = fmaxf(v1[e], 0.f); v0[e] = a * a; v1[e] = b * b; } }
                        u32x4 w; w.x = cvt_pk_bf16(v0[0], v0[1]); w.y = cvt_pk_bf16(v0[2], v0[3]); w.z = cvt_pk_bf16(v1[0], v1[1]); w.w = cvt_pk_bf16(v1[2], v1[3]);
                        *(u32x4*)(rowp + bj * HALF) = w; }
                }
        } else if constexpr (MODE == 4) {
            u32x4 bw[2][4][2];
#pragma unroll
            for (int ai = 0; ai < 2; ++ai)
#pragma unroll
                for (int m = 0; m < 4; ++m)
#pragma unroll
                    for (int bj = 0; bj < 2; ++bj) bw[ai][m][bj] = *(const u32x4*)(pp + (size_t)(row0 + ai * HALF + m * 16) * 1024 + col0 + bj * HALF);
#pragma unroll
            for (int ai = 0; ai < 2; ++ai)
#pragma unroll
                for (int m = 0; m < 4; ++m) {
                    const int row = row0 + ai * HALF + m * 16; bf16_t* xp = O + (size_t)row * 1024 + col0; float q = 0.f;
#pragma unroll
                    for (int bj = 0; bj < 2; ++bj) { f32x4 b0, b1; unpack_bf16x8(bw[ai][m][bj], b0, b1);
                        const f32x4 v0 = acc[ai][bj][m][0] + b0, v1 = acc[ai][bj][m][1] + b1;
                        q += (v0[0] * v0[0] + v0[1] * v0[1]) + (v0[2] * v0[2] + v0[3] * v0[3]) + (v1[0] * v1[0] + v1[1] * v1[1]) + (v1[2] * v1[2] + v1[3] * v1[3]);
                        u32x4 w; w.x = cvt_pk_bf16(v0[0], v0[1]); w.y = cvt_pk_bf16(v0[2], v0[3]); w.z = cvt_pk_bf16(v1[0], v1[1]); w.w = cvt_pk_bf16(v1[2], v1[3]);
                        *(u32x4*)(xp + bj * HALF) = w; }
                    q += __shfl_xor(q, 16); q += __shfl_xor(q, 32);
                    if (fq == 0) sspo[(size_t)row * 16 + u.pn * 4 + wc] = q;
                }
        } else {
            u32x4 xw[4][2][2], pw[4][2][2];
#define EPI3_LOAD(b) do { _Pragma("unroll") for (int r = 0; r < 2; ++r) { const int row = row0 + ((b) >> 1) * HALF + (((b) & 1) * 2 + r) * 16; \
                _Pragma("unroll") for (int bj = 0; bj < 2; ++bj) { xw[b][r][bj] = *(const u32x4*)(O + (size_t)row * 1024 + col0 + bj * HALF); pw[b][r][bj] = *(const u32x4*)(pp + (size_t)row * 1024 + col0 + bj * HALF); } } } while (0)
#define EPI3_DO(b) do { _Pragma("unroll") for (int r = 0; r < 2; ++r) { const int ai = (b) >> 1, m = ((b) & 1) * 2 + r; const int row = row0 + ai * HALF + m * 16; float* op = out + (size_t)row * 1024 + col0; const float s1 = sc[ai][m]; \
                _Pragma("unroll") for (int bj = 0; bj < 2; ++bj) { f32x4 x0, x1, p0, p1; unpack_bf16x8(xw[b][r][bj], x0, x1); unpack_bf16x8(pw[b][r][bj], p0, p1); f32x4 v0, v1; \
                    _Pragma("unroll") for (int e = 0; e < 4; ++e) { const float g0 = 1.0f / (1.0f + __expf(-acc[ai][bj][m][0][e] * s1)), g1 = 1.0f / (1.0f + __expf(-acc[ai][bj][m][1][e] * s1)); v0[e] = x0[e] + g0 * p0[e]; v1[e] = x1[e] + g1 * p1[e]; } \
                    *(f32x4*)(op + bj * HALF) = v0; *(f32x4*)(op + bj * HALF + 4) = v1; } } } while (0)
            EPI3_LOAD(0); EPI3_LOAD(1); EPI3_DO(0); EPI3_LOAD(2); EPI3_DO(1); EPI3_LOAD(3); EPI3_DO(2); EPI3_DO(3);
#undef EPI3_LOAD
#undef EPI3_DO
        }
    }
};

template <class Epi, class Sched, bool ALIGN_EPI = false, bool SP2 = false>
__device__ __forceinline__ void gemm_phase(PG8_LAS unsigned char* lds, const Gemm g, const Sched& S, const Epi& E) {
    const int tid = opaque_tid(), wid = __builtin_amdgcn_readfirstlane(tid >> 6), lane = tid & 63, wr = wid >> 2, wc = wid & 3, fr = lane & 15, fq = lane >> 4;
    const int K = g.K, nt = K / BK;
    unsigned voffA[2], voffB[2];
#pragma unroll
    for (int i = 0; i < 2; ++i) { int R, C; stage_rc(tid * 16 + i * 8192, R, C); const int Rb = Epi::PERM ? ((R & ~31) + perm32(R & 31)) : R;
        voffA[i] = (unsigned)(R * K + C) * 2u; voffB[i] = (unsigned)(Rb * K + C) * 2u; }
    const size_t kstep = (size_t)(BK * 2);
    const size_t hstep = (size_t)HALF * K * 2;
    const size_t tstep = 2 * hstep;
    const unsigned ldsw = (unsigned)wid * 1024u;
    const int aoff = lds_byte(wr * 64 + fr, fq * 8), boff = lds_byte(wc * 32 + fr, fq * 8);
#define PG8_SA(b, h) (((b) * 2 + (h)) * HTB)
#define PG8_SB(b, h) ((4 + (b) * 2 + (h)) * HTB)
#define PG8_STAGE(bufoff, gbase, voff) do { _Pragma("unroll") for (int _i = 0; _i < 2; ++_i) \
        __builtin_amdgcn_global_load_lds((const unsigned*)((const char*)(gbase) + (voff)[_i]), (PG8_LAS unsigned*)(lds + (bufoff) + ldsw + _i * 8192), 16, 0, 0); } while (0)
#define PG8_LDA(dst, b, h) do { _Pragma("unroll") for (int m = 0; m < 4; ++m) _Pragma("unroll") for (int k = 0; k < 2; ++k) dst[m][k] = *(const PG8_LAS bf16x8*)(lds + PG8_SA(b, h) + aoff + m * 2048 + k * 1024); } while (0)
#define PG8_LDB(dst, b, h) do { _Pragma("unroll") for (int n = 0; n < 2; ++n) _Pragma("unroll") for (int k = 0; k < 2; ++k) dst[n][k] = *(const PG8_LAS bf16x8*)(lds + PG8_SB(b, h) + boff + n * 2048 + k * 1024); } while (0)
#define PG8_MMA(ai, bj, At, Bt) do { __builtin_amdgcn_s_setprio(1); _Pragma("unroll") for (int m = 0; m < 4; ++m) _Pragma("unroll") for (int n = 0; n < 2; ++n) _Pragma("unroll") for (int k = 0; k < 2; ++k) \
        acc[ai][bj][m][n] = __builtin_amdgcn_mfma_f32_16x16x32_bf16(Bt[n][k], At[m][k], acc[ai][bj][m][n], 0, 0, 0); __builtin_amdgcn_s_setprio(0); } while (0)
#define PG8_WAIT_V(n) asm volatile("s_waitcnt vmcnt(" #n ")" ::: "memory")
#define PG8_WAIT_L(n) asm volatile("s_waitcnt lgkmcnt(" #n ")" ::: "memory")
#define PG8_BAR __builtin_amdgcn_s_barrier()
#define PG8_SCHED __builtin_amdgcn_sched_barrier(0)
    Unit cur, nxt; int ui = 0;
    if (!S.next(0, cur)) return;
    f32x4 acc[2][2][4][2];
#pragma unroll
    for (int a = 0; a < 2; ++a)
#pragma unroll
        for (int b = 0; b < 2; ++b)
#pragma unroll
            for (int m = 0; m < 4; ++m)
#pragma unroll
                for (int n = 0; n < 2; ++n) acc[a][b][m][n] = (f32x4){0.f, 0.f, 0.f, 0.f};
    bf16x8 At[4][2], B0[2][2], B1[2][2];
    const char* cA = (const char*)g.A + (size_t)cur.pm * tstep; const char* cB = (const char*)g.Bt + (size_t)cur.pn * tstep;
    S.a_ready(cur);
    if constexpr (SP2) {
        PG8_STAGE(PG8_SB(0, 0), cB, voffB); PG8_STAGE(PG8_SB(0, 1), cB + hstep, voffB); PG8_STAGE(PG8_SA(0, 0), cA, voffA); PG8_STAGE(PG8_SA(0, 1), cA + hstep, voffA);
        if (wr == 1) PG8_BAR;
        PG8_WAIT_V(2); PG8_BAR;
        PG8_STAGE(PG8_SB(1, 0), cB + kstep, voffB); PG8_STAGE(PG8_SA(1, 0), cA + kstep, voffA); PG8_STAGE(PG8_SB(1, 1), cB + hstep + kstep, voffB);
        PG8_WAIT_V(6); PG8_BAR;
    } else {
        PG8_STAGE(PG8_SB(0, 0), cB, voffB); PG8_STAGE(PG8_SA(0, 0), cA, voffA); PG8_STAGE(PG8_SB(0, 1), cB + hstep, voffB); PG8_STAGE(PG8_SA(0, 1), cA + hstep, voffA);
        if (wr == 1) PG8_BAR;
        PG8_WAIT_V(4); PG8_BAR;
        PG8_STAGE(PG8_SB(1, 0), cB + kstep, voffB); PG8_STAGE(PG8_SA(1, 0), cA + kstep, voffA); PG8_STAGE(PG8_SB(1, 1), cB + hstep + kstep, voffB);
        PG8_WAIT_V(6); PG8_BAR;
    }
    for (;;) {
        const bool has_next = S.next(ui + 1, nxt);
        const char* nA = has_next ? (const char*)g.A + (size_t)nxt.pm * tstep : cA; const char* nB = has_next ? (const char*)g.Bt + (size_t)nxt.pn * tstep : cB;
        for (int t = 0; t < nt; t += 2) {
            const bool last = (t == nt - 2);
            const char* a1 = cA + (size_t)(t + 1) * kstep;
            const char* a2 = last ? nA : cA + (size_t)(t + 2) * kstep; const char* b2 = last ? nB : cB + (size_t)(t + 2) * kstep;
            const char* a3 = a2 + kstep; const char* b3 = b2 + kstep;
            if (last && has_next) S.a_ready(nxt);
            if constexpr (SP2) {
            PG8_LDB(B0, 0, 0); PG8_LDB(B1, 0, 1); PG8_SCHED; PG8_LDA(At, 0, 0); PG8_STAGE(PG8_SA(1, 1), a1 + hstep, voffA);
            PG8_WAIT_V(8); PG8_WAIT_L(0); PG8_BAR; PG8_MMA(0, 0, At, B0); PG8_MMA(0, 1, At, B1); PG8_BAR; PG8_SCHED;
            PG8_LDA(At, 0, 1); PG8_STAGE(PG8_SB(0, 0), b2, voffB); PG8_STAGE(PG8_SB(0, 1), b2 + hstep, voffB); PG8_STAGE(PG8_SA(0, 0), a2, voffA);
            PG8_WAIT_V(8); PG8_WAIT_L(0); PG8_BAR; PG8_MMA(1, 0, At, B0); PG8_MMA(1, 1, At, B1); PG8_BAR; PG8_SCHED;
            PG8_LDB(B0, 1, 0); PG8_LDB(B1, 1, 1); PG8_SCHED; PG8_LDA(At, 1, 0); PG8_STAGE(PG8_SA(0, 1), a2 + hstep, voffA);
            PG8_WAIT_V(8); PG8_WAIT_L(0); PG8_BAR; PG8_MMA(0, 0, At, B0); PG8_MMA(0, 1, At, B1); PG8_BAR; PG8_SCHED;
            PG8_LDA(At, 1, 1); PG8_STAGE(PG8_SB(1, 0), b3, voffB); PG8_STAGE(PG8_SB(1, 1), b3 + hstep, voffB); PG8_STAGE(PG8_SA(1, 0), a3, voffA);
            PG8_WAIT_V(8); PG8_WAIT_L(0); PG8_BAR; PG8_MMA(1, 0, At, B0); PG8_MMA(1, 1, At, B1); PG8_BAR; PG8_SCHED;
            } else {
            PG8_LDB(B0, 0, 0); PG8_SCHED; PG8_LDA(At, 0, 0); PG8_STAGE(PG8_SA(1, 1), a1 + hstep, voffA);
            PG8_WAIT_L(8); PG8_BAR; PG8_WAIT_L(0); PG8_MMA(0, 0, At, B0); PG8_BAR; PG8_SCHED;
            PG8_LDB(B1, 0, 1); PG8_STAGE(PG8_SB(0, 0), b2, voffB);
            PG8_BAR; PG8_WAIT_L(0); PG8_MMA(0, 1, At, B1); PG8_BAR;
            PG8_LDA(At, 0, 1); PG8_STAGE(PG8_SA(0, 0), a2, voffA);
            PG8_BAR; PG8_WAIT_L(0); PG8_MMA(1, 0, At, B0); PG8_BAR; PG8_SCHED;
            PG8_STAGE(PG8_SB(0, 1), b2 + hstep, voffB);
            PG8_WAIT_V(6); PG8_BAR; PG8_MMA(1, 1, At, B1); PG8_BAR;
            PG8_LDB(B0, 1, 0); PG8_SCHED; PG8_LDA(At, 1, 0); PG8_STAGE(PG8_SA(0, 1), a2 + hstep, voffA);
            PG8_WAIT_L(8); PG8_BAR; PG8_WAIT_L(0); PG8_MMA(0, 0, At, B0); PG8_BAR; PG8_SCHED;
            PG8_LDB(B1, 1, 1); PG8_STAGE(PG8_SB(1, 0), b3, voffB);
            PG8_BAR; PG8_WAIT_L(0); PG8_MMA(0, 1, At, B1); PG8_BAR;
            PG8_LDA(At, 1, 1); PG8_STAGE(PG8_SA(1, 0), a3, voffA);
            PG8_BAR; PG8_WAIT_L(0); PG8_MMA(1, 0, At, B0); PG8_BAR; PG8_SCHED;
            PG8_STAGE(PG8_SB(1, 1), b3 + hstep, voffB);
            PG8_WAIT_V(6); PG8_BAR; PG8_MMA(1, 1, At, B1); PG8_BAR;
            }
        }
        if constexpr (ALIGN_EPI) { if (wr == 0) PG8_BAR; }
        if constexpr (!Epi::AFTER_DRAIN) { E(acc, cur, wr, wc, fr, fq); S.done(cur); }
        if (!has_next) break;
#pragma unroll
        for (int a = 0; a < 2; ++a)
#pragma unroll
            for (int b = 0; b < 2; ++b)
#pragma unroll
                for (int m = 0; m < 4; ++m)
#pragma unroll
                    for (int n = 0; n < 2; ++n) acc[a][b][m][n] = (f32x4){0.f, 0.f, 0.f, 0.f};
        cur = nxt; cA = nA; cB = nB; ++ui;
        if constexpr (ALIGN_EPI) { if (wr == 1) PG8_BAR; }
    }
    PG8_WAIT_V(0);
    if constexpr (!ALIGN_EPI) { if (wr == 0) PG8_BAR; }
    PG8_BAR;
    if constexpr (Epi::AFTER_DRAIN) { E.fused(acc, cur, wr, wc, fr, fq, lds, wid, lane); S.done(cur); }
#undef PG8_SA
#undef PG8_SB
#undef PG8_STAGE
#undef PG8_LDA
#undef PG8_LDB
#undef PG8_MMA
#undef PG8_WAIT_V
#undef PG8_WAIT_L
#undef PG8_BAR
#undef PG8_SCHED
}
}
#define LAS __attribute__((address_space(3)))
typedef unsigned short bf16;
typedef unsigned v4u __attribute__((ext_vector_type(4)));
typedef unsigned v2u __attribute__((ext_vector_type(2)));
typedef float f32x4 __attribute__((ext_vector_type(4)));
typedef short s16x8 __attribute__((ext_vector_type(8)));
typedef short s16x4 __attribute__((ext_vector_type(4)));

constexpr int D = 1024, MP = 16384, MS = 512, M = MP + MS, NIN = 2304, FF = 4096, PLE = 256, SEQ = 2048, NWAVES = 8;
constexpr float EPS = 1e-6f;
constexpr float LOG2E = 1.4426950408889634f;
constexpr size_t MiB = 1u << 20;
constexpr size_t WS_RSTD0 = 0, WS_BAR = 96 * 1024, WS_BAR_BYTES = 16 * 1024, WS_ROPE = 128 * 1024, WS_SS1 = 1 * MiB, WS_SS2 = 3 * MiB;
constexpr size_t WS_WIN = 6 * MiB, WS_WO = WS_WIN + (size_t)NIN * D * 2, WS_WUP = WS_WO + 2 * MiB, WS_WDN = WS_WUP + 8 * MiB, WS_WG = WS_WDN + 8 * MiB, WS_WP = WS_WG + 2 * MiB;
constexpr size_t WS_PB = 31 * MiB, WS_U = 40 * MiB, WS_Z = 40 * MiB, WS_XB = 115 * MiB, WS_PPB = 40 * MiB, WS_X1B = 172 * MiB, WS_MIXED = 205 * MiB, WS_X2B = 205 * MiB, WS_END = 238 * MiB;
static_assert(WS_WP + (size_t)D * PLE * 2 <= WS_PB && WS_PB + (size_t)M * PLE * 2 <= WS_U && WS_Z + (size_t)M * NIN * 2 <= WS_XB && WS_XB + (size_t)M * D * 2 <= WS_X1B && WS_U + (size_t)M * FF * 2 <= WS_X1B && WS_X1B + (size_t)M * D * 2 <= WS_MIXED && WS_MIXED + (size_t)M * D * 2 <= WS_END, "ws map");
static_assert(WS_ROPE + 2052 * 64 * 4 <= WS_SS1 && WS_SS1 + (size_t)M * 64 <= WS_SS2 && WS_SS2 + (size_t)M * 64 <= WS_WIN, "ws map (small)");
constexpr size_t OFF_YP = 0, OFF_YS = (size_t)MP * D, OFF_KP = OFF_YS + (size_t)MS * D, OFF_VP = OFF_KP + 8 * 128 * 128, OFF_CP = OFF_VP + 8 * 128 * 128,
                 OFF_KS = OFF_CP + 8 * 2 * 512, OFF_VS = OFF_KS + 128 * 128 * 128, OFF_CS = OFF_VS + 128 * 128 * 128, OUT_TOTAL = OFF_CS + 128 * 2 * 512;
constexpr int LDS_BYTES = 147456;

#define LDS_WAIT() asm volatile("s_waitcnt lgkmcnt(0)" ::: "memory")
__device__ __forceinline__ unsigned pk2(float lo, float hi) { return pg8::cvt_pk_bf16(lo, hi); }
__device__ __forceinline__ float bflo(unsigned w) { return __uint_as_float(w << 16); }
__device__ __forceinline__ float bfhi(unsigned w) { return __uint_as_float(w & 0xffff0000u); }
__device__ __forceinline__ void unpack8(const v4u w, float (&x)[8]) { x[0] = bflo(w.x); x[1] = bfhi(w.x); x[2] = bflo(w.y); x[3] = bfhi(w.y); x[4] = bflo(w.z); x[5] = bfhi(w.z); x[6] = bflo(w.w); x[7] = bfhi(w.w); }
__device__ __forceinline__ v4u pack8(const float (&x)[8]) { v4u o; o.x = pk2(x[0], x[1]); o.y = pk2(x[2], x[3]); o.z = pk2(x[4], x[5]); o.w = pk2(x[6], x[7]); return o; }
__device__ __forceinline__ float wave_sum(float v) {
#pragma unroll
    for (int o = 1; o < 64; o <<= 1) v += __shfl_xor(v, o);
    return v;
}

struct Args { const float* in[22]; float* out; unsigned char* ws; int ph_lo, ph_hi; };

__device__ __forceinline__ void p0_transpose_item(const float* W, int K, int N, bf16* WT, const float* g, LAS float* scr, int k0, int n0, int lane) {
    const int r8 = lane >> 3, c4 = (lane & 7) * 4;
    f32x4 v[8];
#pragma unroll
    for (int i = 0; i < 8; ++i) v[i] = *(const f32x4*)(W + (size_t)(k0 + 8 * i + r8) * N + n0 + c4);
#pragma unroll
    for (int i = 0; i < 8; ++i) { const int kk = 8 * i + r8; const float gv = g ? g[kk] : 1.0f; LAS float* d = scr + kk * 33 + c4;
        d[0] = v[i][0] * gv; d[1] = v[i][1] * gv; d[2] = v[i][2] * gv; d[3] = v[i][3] * gv; }
    LDS_WAIT(); asm volatile("" ::: "memory");
    const int c = lane & 7;
#pragma unroll
    for (int j = 0; j < 4; ++j) { const int n = (lane >> 3) + 8 * j; const LAS float* s = scr + (8 * c) * 33 + n;
        v4u o; o.x = pk2(s[0 * 33], s[1 * 33]); o.y = pk2(s[2 * 33], s[3 * 33]); o.z = pk2(s[4 * 33], s[5 * 33]); o.w = pk2(s[6 * 33], s[7 * 33]);
        *(v4u*)(WT + (size_t)(n0 + n) * K + k0 + 8 * c) = o; }
    LDS_WAIT(); asm volatile("" ::: "memory");
}
constexpr int P1_LIGHT0 = 82;
__device__ __forceinline__ void p0_weights(const Args& a, LAS unsigned char* lds, int set, int gw, int NGW, int it_end = 1 << 30) {
    const int lane = opaque_tid() & 63, wave = __builtin_amdgcn_readfirstlane(opaque_tid() >> 6);
    unsigned char* ws = a.ws;
    LAS float* scr = (LAS float*)(lds + wave * 16384);
    constexpr int I_IN = 16 * (NIN / 32), I_O = 16 * 32, I_UP = 16 * (FF / 32), I_DN = 64 * 32, I_G = 16 * 32, I_P = 4 * 32;
    const int nitems = set == 0 ? I_IN + I_O + I_P : I_UP + I_DN + I_G;
    const int itend = it_end < nitems ? it_end : nitems;
    for (int it = gw; it < itend; it += NGW) {
        int r = it; const float* W; const float* g; bf16* WT; int K, N;
        if (set == 0) {
            if (r < I_IN) { W = a.in[8]; g = a.in[7]; WT = (bf16*)(ws + WS_WIN); K = D; N = NIN; }
            else if ((r -= I_IN) < I_O) { W = a.in[15]; g = nullptr; WT = (bf16*)(ws + WS_WO); K = D; N = D; }
            else { r -= I_O; W = a.in[21]; g = nullptr; WT = (bf16*)(ws + WS_WP); K = PLE; N = D; }
        } else {
            if (r < I_UP) { W = a.in[17]; g = a.in[16]; WT = (bf16*)(ws + WS_WUP); K = D; N = FF; }
            else if ((r -= I_UP) < I_DN) { W = a.in[18]; g = nullptr; WT = (bf16*)(ws + WS_WDN); K = FF; N = D; }
            else { r -= I_DN; W = a.in[20]; g = a.in[19]; WT = (bf16*)(ws + WS_WG); K = D; N = D; }
        }
        const int nblk = N / 32, k0 = 64 * (r / nblk), n0 = 32 * (r % nblk);
        if (W == a.in[15]) g = (k0 < 512) ? a.in[13] + k0 : a.in[14] + (k0 - 512); else if (g) g += k0;
        p0_transpose_item(W, K, N, WT, g, scr, k0, n0, lane);
    }
}
__device__ __forceinline__ void p0_prologue(const Args& a, LAS unsigned char* lds, int G) {
    const int tid = opaque_tid(), lane = tid & 63, wave = __builtin_amdgcn_readfirstlane(tid >> 6);
    unsigned char* ws = a.ws;
    const int gw = opaque_bid() * NWAVES + wave, NGW = G * NWAVES;
    p0_weights(a, lds, 0, gw, NGW);
    float* rstd0 = (float*)(ws + WS_RSTD0); bf16* XB = (bf16*)(ws + WS_XB); bf16* PB = (bf16*)(ws + WS_PB);
    for (int m0 = 2 * gw; m0 < M; m0 += 2 * NGW) {
        f32x4 v[2][4]; f32x4 pv[2];
#pragma unroll
        for (int h = 0; h < 2; ++h) { const int m = m0 + h;
            const float* xrow = m < MP ? a.in[0] + (size_t)m * D : a.in[1] + (size_t)(m - MP) * D; const f32x4* xr = (const f32x4*)xrow + lane;
#pragma unroll
            for (int j = 0; j < 4; ++j) v[h][j] = xr[64 * j];
            const float* prow = m < MP ? a.in[2] + (size_t)m * PLE : a.in[3] + (size_t)(m - MP) * PLE; pv[h] = ((const f32x4*)prow)[lane]; }
#pragma unroll
        for (int h = 0; h < 2; ++h) { const int m = m0 + h; float s = 0.f;
#pragma unroll
            for (int j = 0; j < 4; ++j) s += (v[h][j].x * v[h][j].x + v[h][j].y * v[h][j].y) + (v[h][j].z * v[h][j].z + v[h][j].w * v[h][j].w);
            s = wave_sum(s);
            if (lane == 0) rstd0[m] = rsqrtf(s * (1.0f / D) + EPS);
            v2u* o8 = (v2u*)(XB + (size_t)m * D) + lane;
#pragma unroll
            for (int j = 0; j < 4; ++j) { v2u o; o.x = pk2(v[h][j].x, v[h][j].y); o.y = pk2(v[h][j].z, v[h][j].w); o8[64 * j] = o; }
            v2u po; po.x = pk2(pv[h].x, pv[h].y); po.y = pk2(pv[h].z, pv[h].w); ((v2u*)(PB + (size_t)m * PLE))[lane] = po; }
    }
    float* rope = (float*)(ws + WS_ROPE);
    for (int idx = opaque_bid() * 512 + tid; idx < 2052 * 32; idx += G * 512) {
        const int pi = idx >> 5, i = idx & 31; const int pos = pi < 2048 ? pi : 16384 + (pi - 2048);
        const float inv_freq = exp2f(-(float)i * 0.41524101186092029f);
        const float ang = (float)pos * inv_freq;
        const double rev = (double)ang * 0.15915494309189535; const float fr = (float)(rev - floor(rev));
        rope[pi * 64 + i] = __builtin_amdgcn_cosf(fr); rope[pi * 64 + 32 + i] = __builtin_amdgcn_sinf(fr);
    }
}
constexpr int KST = 72, VST = 200, KROWS = 192;
constexpr int MX_KS = 0, MX_VT = 2 * KROWS * KST * 2, MX_RED = MX_VT + 2 * 64 * VST * 2;
static_assert(MX_RED + 64 * 8 * 4 <= 131072, "mixer LDS");

__device__ __forceinline__ void k_norm_rope(float (&x)[8], int j, const float* g, const float* rp) {
    float ss = 0.f;
#pragma unroll
    for (int e = 0; e < 8; ++e) ss += x[e] * x[e];
    ss += __shfl_xor(ss, 1); ss += __shfl_xor(ss, 2); ss += __shfl_xor(ss, 4);
    const float rstd = rsqrtf(ss * (1.0f / 64.0f) + EPS);
    const f32x4 g0 = *(const f32x4*)(g + 8 * j), g1 = *(const f32x4*)(g + 8 * j + 4);
    const int i0 = 8 * (j & 3);
    const f32x4 c0 = *(const f32x4*)(rp + i0), c1 = *(const f32x4*)(rp + i0 + 4), s0 = *(const f32x4*)(rp + 32 + i0), s1 = *(const f32x4*)(rp + 32 + i0 + 4);
    const float sg = (j < 4) ? -1.0f : 1.0f;
#pragma unroll
    for (int e = 0; e < 8; ++e) {
        const float y = x[e] * rstd * (e < 4 ? g0[e & 3] : g1[e & 3]);
        const float p = __shfl_xor(y, 4);
        const float c = e < 4 ? c0[e & 3] : c1[e & 3], s = e < 4 ? s0[e & 3] : s1[e & 3];
        x[e] = y * c + sg * p * s;
    }
}
__device__ __forceinline__ void q_frag_raw(const v4u w0, const v4u w1, const float* gq, const float* rp, int fq, s16x8& q0, s16x8& q1) {
    float x0[8], x1[8]; unpack8(w0, x0); unpack8(w1, x1);
    float ss = 0.f;
#pragma unroll
    for (int e = 0; e < 8; ++e) ss += x0[e] * x0[e] + x1[e] * x1[e];
    ss += __shfl_xor(ss, 16); ss += __shfl_xor(ss, 32);
    const float rstd = rsqrtf(ss * (1.0f / 64.0f) + EPS) * (LOG2E * 0.125f);
    const f32x4 ga = *(const f32x4*)(gq + 8 * fq), gb = *(const f32x4*)(gq + 8 * fq + 4), gc = *(const f32x4*)(gq + 32 + 8 * fq), gd = *(const f32x4*)(gq + 36 + 8 * fq);
    const f32x4 ca = *(const f32x4*)(rp + 8 * fq), cb = *(const f32x4*)(rp + 8 * fq + 4), sa = *(const f32x4*)(rp + 32 + 8 * fq), sb = *(const f32x4*)(rp + 36 + 8 * fq);
    float o0[8], o1[8];
#pragma unroll
    for (int e = 0; e < 8; ++e) {
        const float y0 = x0[e] * rstd * (e < 4 ? ga[e & 3] : gb[e & 3]), y1 = x1[e] * rstd * (e < 4 ? gc[e & 3] : gd[e & 3]);
        const float c = e < 4 ? ca[e & 3] : cb[e & 3], sn = e < 4 ? sa[e & 3] : sb[e & 3];
        o0[e] = y0 * c - y1 * sn; o1[e] = y1 * c + y0 * sn;
    }
    const v4u p0 = pack8(o0), p1 = pack8(o1);
    q0 = __builtin_bit_cast(s16x8, p0); q1 = __builtin_bit_cast(s16x8, p1);
}
__device__ __forceinline__ void q_frag(const bf16* zq  , const float* gq, const float* rp, int fq, s16x8& q0, s16x8& q1) {
    const v4u w0 = *(const v4u*)(zq + 8 * fq), w1 = *(const v4u*)(zq + 32 + 8 * fq);
    q_frag_raw(w0, w1, gq, rp, fq, q0, q1);
}
__device__ __forceinline__ void attn_strip(const LAS bf16* Ks, const LAS bf16* Vt, const s16x8 q0, const s16x8 q1, int tl, int jmin, float sink2, int fr, int fq, f32x4 (&O)[4]) {
    f32x4 S[9];
#pragma unroll
    for (int kt = 0; kt < 9; ++kt) {
        const LAS bf16* kp = Ks + (16 * kt + fr) * KST + 8 * fq;
        const s16x8 a0 = *(const LAS s16x8*)kp, a1 = *(const LAS s16x8*)(kp + 32);
        f32x4 c = {0.f, 0.f, 0.f, 0.f};
        c = __builtin_amdgcn_mfma_f32_16x16x32_bf16(a0, q0, c, 0, 0, 0);
        c = __builtin_amdgcn_mfma_f32_16x16x32_bf16(a1, q1, c, 0, 0, 0);
        S[kt] = c;
    }
    float mx = sink2;
#pragma unroll
    for (int i = 0; i < 4; ++i) { const int j0 = 4 * fq + i; if (!(j0 > tl)) S[0][i] = -1e30f; if (!(j0 <= tl)) S[8][i] = -1e30f; }
    if (jmin > 0) {
#pragma unroll
        for (int kt = 0; kt < 9; ++kt)
#pragma unroll
            for (int i = 0; i < 4; ++i) if (16 * kt + 4 * fq + i < jmin) S[kt][i] = -1e30f;
    }
#pragma unroll
    for (int kt = 0; kt < 9; ++kt)
#pragma unroll
        for (int i = 0; i < 4; ++i) mx = fmaxf(mx, S[kt][i]);
    mx = fmaxf(mx, __shfl_xor(mx, 16)); mx = fmaxf(mx, __shfl_xor(mx, 32));
    float sum = 0.f;
#pragma unroll
    for (int kt = 0; kt < 9; ++kt)
#pragma unroll
        for (int i = 0; i < 4; ++i) { const float e = __builtin_amdgcn_exp2f(S[kt][i] - mx); S[kt][i] = e; sum += e; }
    sum += __shfl_xor(sum, 16); sum += __shfl_xor(sum, 32);
    const float inv = 1.0f / (sum + __builtin_amdgcn_exp2f(sink2 - mx));
#pragma unroll
    for (int dt = 0; dt < 4; ++dt) O[dt] = (f32x4){0.f, 0.f, 0.f, 0.f};
#pragma unroll
    for (int p = 0; p < 4; ++p) {
        v4u pw; pw.x = pk2(S[2 * p][0] * inv, S[2 * p][1] * inv); pw.y = pk2(S[2 * p][2] * inv, S[2 * p][3] * inv); pw.z = pk2(S[2 * p + 1][0] * inv, S[2 * p + 1][1] * inv); pw.w = pk2(S[2 * p + 1][2] * inv, S[2 * p + 1][3] * inv);
        const s16x8 pb = __builtin_bit_cast(s16x8, pw);
#pragma unroll
        for (int dt = 0; dt < 4; ++dt) {
            const LAS bf16* vp = Vt + (16 * dt + fr) * VST + 32 * p + 4 * fq;
            const v2u lo = *(const LAS v2u*)vp, hi = *(const LAS v2u*)(vp + 16);
            const v4u va4 = (v4u){lo.x, lo.y, hi.x, hi.y};
            O[dt] = __builtin_amdgcn_mfma_f32_16x16x32_bf16(__builtin_bit_cast(s16x8, va4), pb, O[dt], 0, 0, 0);
        }
    }
    {
        v2u pw; pw.x = pk2(S[8][0] * inv, S[8][1] * inv); pw.y = pk2(S[8][2] * inv, S[8][3] * inv);
        const s16x4 pb = __builtin_bit_cast(s16x4, pw);
#pragma unroll
        for (int dt = 0; dt < 4; ++dt) {
            const s16x4 va = *(const LAS s16x4*)(Vt + (16 * dt + fr) * VST + 128 + 4 * fq);
            O[dt] = __builtin_amdgcn_mfma_f32_16x16x16bf16_1k(va, pb, O[dt], 0, 0, 0);
        }
    }
}
__device__ __forceinline__ void load_u(int mode, const bf16* z, size_t zrow, const float* st, int ch, float (&u)[8]) {
    if (mode == 1) { const v4u c = *(const v4u*)(z + zrow * NIN + 1280 + ch), h = *(const v4u*)(z + zrow * NIN + 1792 + ch); float a[8], b[8]; unpack8(c, a); unpack8(h, b);
#pragma unroll
        for (int e = 0; e < 8; ++e) u[e] = a[e] * b[e]; }
    else if (mode == 2) { const f32x4 a = *(const f32x4*)(st + ch), b = *(const f32x4*)(st + ch + 4); u[0] = a[0]; u[1] = a[1]; u[2] = a[2]; u[3] = a[3]; u[4] = b[0]; u[5] = b[1]; u[6] = b[2]; u[7] = b[3]; }
    else {
#pragma unroll
        for (int e = 0; e < 8; ++e) u[e] = 0.f; }
}
__device__ __forceinline__ void conv_token(const bf16* z, bf16* mixed, const float* convw, size_t row, int m1, size_t r1, const float* s1, int m2, size_t r2, const float* s2, float* u0out, int lane) {
    const int ch = 8 * lane; float u0[8], u1[8], u2[8];
    load_u(1, z, row, nullptr, ch, u0); load_u(m1, z, r1, s1, ch, u1); load_u(m2, z, r2, s2, ch, u2);
    const v4u bw = *(const v4u*)(z + row * NIN + 768 + ch); float bg[8]; unpack8(bw, bg);
    float w0[8], w1[8], w2[8];
#pragma unroll
    for (int h = 0; h < 2; ++h) { const f32x4 a = *(const f32x4*)(convw + ch + 4 * h), b = *(const f32x4*)(convw + 512 + ch + 4 * h), c = *(const f32x4*)(convw + 1024 + ch + 4 * h);
#pragma unroll
        for (int e = 0; e < 4; ++e) { w0[4 * h + e] = a[e]; w1[4 * h + e] = b[e]; w2[4 * h + e] = c[e]; } }
    float o[8]; float ss = 0.f;
#pragma unroll
    for (int e = 0; e < 8; ++e) { o[e] = bg[e] * (w0[e] * u2[e] + w1[e] * u1[e] + w2[e] * u0[e]); ss += o[e] * o[e]; }
    ss = wave_sum(ss);
    const float rstd = rsqrtf(ss * (1.0f / 512.0f) + EPS);
#pragma unroll
    for (int e = 0; e < 8; ++e) o[e] *= rstd;
    *(v4u*)(mixed + row * D + 512 + ch) = pack8(o);
    if (u0out) { *(f32x4*)(u0out + ch) = (f32x4){u0[0], u0[1], u0[2], u0[3]}; *(f32x4*)(u0out + ch + 4) = (f32x4){u0[4], u0[5], u0[6], u0[7]}; }
}

__device__ __forceinline__ void conv_tokens4(const bf16* z, bf16* mixed, const float* convw, size_t row0, int t, float* cp_out  , int lane) {
    const int ch = 8 * lane;
    v4u cw[6], hw[6], bw[4];
#pragma unroll
    for (int i = 0; i < 6; ++i) { const bool ok = (t + i - 2) >= 0; const size_t r = ok ? row0 + i - 2 : row0; cw[i] = *(const v4u*)(z + r * NIN + 1280 + ch); hw[i] = *(const v4u*)(z + r * NIN + 1792 + ch);
        if (!ok) { cw[i] = (v4u){0u, 0u, 0u, 0u}; } }
#pragma unroll
    for (int i = 0; i < 4; ++i) bw[i] = *(const v4u*)(z + (row0 + i) * NIN + 768 + ch);
    float w0[8], w1[8], w2[8];
#pragma unroll
    for (int h = 0; h < 2; ++h) { const f32x4 a = *(const f32x4*)(convw + ch + 4 * h), b = *(const f32x4*)(convw + 512 + ch + 4 * h), c = *(const f32x4*)(convw + 1024 + ch + 4 * h);
#pragma unroll
        for (int e = 0; e < 4; ++e) { w0[4 * h + e] = a[e]; w1[4 * h + e] = b[e]; w2[4 * h + e] = c[e]; } }
    float u[6][8];
#pragma unroll
    for (int i = 0; i < 6; ++i) { float a[8], b[8]; unpack8(cw[i], a); unpack8(hw[i], b);
#pragma unroll
        for (int e = 0; e < 8; ++e) u[i][e] = a[e] * b[e]; }
#pragma unroll
    for (int i = 0; i < 4; ++i) {
        float bg[8]; unpack8(bw[i], bg); float o[8]; float ss = 0.f;
#pragma unroll
        for (int e = 0; e < 8; ++e) { o[e] = bg[e] * (w0[e] * u[i][e] + w1[e] * u[i + 1][e] + w2[e] * u[i + 2][e]); ss += o[e] * o[e]; }
        ss = wave_sum(ss);
        const float rstd = rsqrtf(ss * (1.0f / 512.0f) + EPS);
#pragma unroll
        for (int e = 0; e < 8; ++e) o[e] *= rstd;
        *(v4u*)(mixed + (row0 + i) * D + 512 + ch) = pack8(o);
        if (cp_out && t + i >= SEQ - 2) { float* uo = cp_out + (size_t)(t + i - (SEQ - 2)) * 512 + ch;
            *(f32x4*)uo = (f32x4){u[i + 2][0], u[i + 2][1], u[i + 2][2], u[i + 2][3]}; *(f32x4*)(uo + 4) = (f32x4){u[i + 2][4], u[i + 2][5], u[i + 2][6], u[i + 2][7]}; }
    }
}

struct MixP { const bf16* z; bf16* mixed; const float* rope; const float *gq, *gk, *sinks, *convw, *cache_k, *cache_v, *state_conv; float* out; };

__device__ __forceinline__ void mixer_prompt_unit(const MixP& P, LAS unsigned char* lds, int b, int jblk, int conv_nb  ) {
    const int tid = opaque_tid(), lane = tid & 63, w = __builtin_amdgcn_readfirstlane(tid >> 6), fr = lane & 15, fq = lane >> 4;
    const int t0 = 64 * jblk; const bf16* z = P.z;
    v4u qraw[4][2];
#pragma unroll
    for (int s = 0; s < 4; ++s) { const bf16* zq = z + (size_t)(b * SEQ + t0 + 16 * s + fr) * NIN + w * 64; qraw[s][0] = *(const v4u*)(zq + 8 * fq); qraw[s][1] = *(const v4u*)(zq + 32 + 8 * fq); }
#pragma unroll
    for (int p = 0; p < 6; ++p) {
        const int id = p * 512 + tid, rowid = id >> 3, j = id & 7, kvh = rowid >= KROWS ? 1 : 0, r = rowid - KROWS * kvh;
        const int t = t0 - 128 + r; const bool valid = t >= 0; const int tc = valid ? t : 0;
        const v4u wv = *(const v4u*)(z + (size_t)(b * SEQ + tc) * NIN + 512 + kvh * 64 + 8 * j);
        float x[8]; unpack8(wv, x);
        k_norm_rope(x, j, P.gk, P.rope + tc * 64);
        if (!valid) {
#pragma unroll
            for (int e = 0; e < 8; ++e) x[e] = 0.f; }
        *(LAS v4u*)(lds + MX_KS + ((kvh * KROWS + r) * KST + 8 * j) * 2) = pack8(x);
        if (r >= 128 && t >= SEQ - 128) { float* kp = P.out + OFF_KP + ((size_t)((b * 128 + (t - (SEQ - 128))) * 2 + kvh)) * 64 + 8 * j;
            *(f32x4*)kp = (f32x4){x[0], x[1], x[2], x[3]}; *(f32x4*)(kp + 4) = (f32x4){x[4], x[5], x[6], x[7]}; }
    }
    for (int p = 0; p < 2; ++p) {
        const int id = p * 512 + tid;
        if (id < 768) {
            const int dc = id & 7, kg = (id >> 3) % 48, kvh = id / 384; float v[4][8];
#pragma unroll
            for (int kk = 0; kk < 4; ++kk) { const int r = 4 * kg + kk, t = t0 - 128 + r;
                if (t >= 0) { const v4u wv = *(const v4u*)(z + (size_t)(b * SEQ + t) * NIN + 640 + kvh * 64 + 8 * dc); unpack8(wv, v[kk]); }
                else {
#pragma unroll
                    for (int e = 0; e < 8; ++e) v[kk][e] = 0.f; }
                if (r >= 128 && t >= SEQ - 128) { float* vp = P.out + OFF_VP + ((size_t)((b * 128 + (t - (SEQ - 128))) * 2 + kvh)) * 64 + 8 * dc;
                    *(f32x4*)vp = (f32x4){v[kk][0], v[kk][1], v[kk][2], v[kk][3]}; *(f32x4*)(vp + 4) = (f32x4){v[kk][4], v[kk][5], v[kk][6], v[kk][7]}; } }
#pragma unroll
            for (int e = 0; e < 8; ++e) { v2u o; o.x = pk2(v[0][e], v[1][e]); o.y = pk2(v[2][e], v[3][e]); *(LAS v2u*)(lds + MX_VT + ((kvh * 64 + 8 * dc + e) * VST + 4 * kg) * 2) = o; }
        }
    }
    __syncthreads();
    f32x4 O[4][4]; LAS float* red = (LAS float*)(lds + MX_RED);
    const int kvh = w >> 2; const float sink2 = P.sinks[w] * LOG2E;
#pragma unroll
    for (int s = 0; s < 4; ++s) {
        const int tq = t0 + 16 * s + fr; s16x8 q0, q1;
        q_frag_raw(qraw[s][0], qraw[s][1], P.gq, P.rope + tq * 64, fq, q0, q1);
        attn_strip((const LAS bf16*)(lds + MX_KS) + (kvh * KROWS + 16 * s) * KST, (const LAS bf16*)(lds + MX_VT) + kvh * 64 * VST + 16 * s, q0, q1, fr, 128 - t0 - 16 * s, sink2, fr, fq, O[s]);
        float q = 0.f;
#pragma unroll
        for (int dt = 0; dt < 4; ++dt) q += (O[s][dt][0] * O[s][dt][0] + O[s][dt][1] * O[s][dt][1]) + (O[s][dt][2] * O[s][dt][2] + O[s][dt][3] * O[s][dt][3]);
        q += __shfl_xor(q, 16); q += __shfl_xor(q, 32);
        if (fq == 0) red[(16 * s + fr) * 8 + w] = q;
        __builtin_amdgcn_sched_barrier(0);
    }
    __syncthreads();
#pragma unroll
    for (int s = 0; s < 4; ++s) {
        const LAS f32x4* rr = (const LAS f32x4*)(red + (16 * s + fr) * 8); const f32x4 a = rr[0], c = rr[1];
        const float rstd = rsqrtf(((a[0] + a[1]) + (a[2] + a[3]) + (c[0] + c[1]) + (c[2] + c[3])) * (1.0f / 512.0f) + EPS);
        bf16* mp = P.mixed + (size_t)(b * SEQ + t0 + 16 * s + fr) * D + w * 64 + 4 * fq;
#pragma unroll
        for (int dt = 0; dt < 4; ++dt) { v2u o; o.x = pk2(O[s][dt][0] * rstd, O[s][dt][1] * rstd); o.y = pk2(O[s][dt][2] * rstd, O[s][dt][3] * rstd); *(v2u*)(mp + 16 * dt) = o; }
    }
    for (int i = 0; i < conv_nb; ++i) {
        const int t = t0 + 4 * (8 * i + w);
        conv_tokens4(z, P.mixed, P.convw, (size_t)b * SEQ + t, t, (t + 4 > SEQ - 2) ? P.out + OFF_CP + (size_t)b * 2 * 512 : nullptr, lane);
    }
    __syncthreads();
}

__device__ __forceinline__ void mixer_conv_half(const MixP& P, int b, int jblk) {
    const int lane = threadIdx.x & 63, w = __builtin_amdgcn_readfirstlane((int)(threadIdx.x >> 6));
    const int t = 64 * jblk + 4 * (8 + w);
    conv_tokens4(P.z, P.mixed, P.convw, (size_t)b * SEQ + t, t, (t + 4 > SEQ - 2) ? P.out + OFF_CP + (size_t)b * 2 * 512 : nullptr, lane);
}
__device__ __forceinline__ void mixer_sample_unit(const MixP& P, LAS unsigned char* lds, int sq) {
    const int tid = opaque_tid(), lane = tid & 63, w = __builtin_amdgcn_readfirstlane(tid >> 6), fr = lane & 15, fq = lane >> 4;
    const bf16* z = P.z; const size_t zr0 = (size_t)MP + 4 * sq;
    {
        f32x4 ca[4][2];
#pragma unroll
        for (int p = 0; p < 4; ++p) { const int id = p * 512 + tid, rowid = id >> 3, j = id & 7, kvh = rowid >> 7, r = rowid & 127;
            const float* cp = P.cache_k + ((size_t)(sq * 128 + r) * 2 + kvh) * 64 + 8 * j; ca[p][0] = *(const f32x4*)cp; ca[p][1] = *(const f32x4*)(cp + 4); }
#pragma unroll
        for (int p = 0; p < 4; ++p) { const int id = p * 512 + tid, rowid = id >> 3, j = id & 7, kvh = rowid >> 7, r = rowid & 127;
            v4u o; o.x = pk2(ca[p][0][0], ca[p][0][1]); o.y = pk2(ca[p][0][2], ca[p][0][3]); o.z = pk2(ca[p][1][0], ca[p][1][1]); o.w = pk2(ca[p][1][2], ca[p][1][3]);
            *(LAS v4u*)(lds + MX_KS + ((kvh * KROWS + r) * KST + 8 * j) * 2) = o;
            if (r >= 4) { float* kp = P.out + OFF_KS + ((size_t)(sq * 128 + (r - 4)) * 2 + kvh) * 64 + 8 * j; *(f32x4*)kp = ca[p][0]; *(f32x4*)(kp + 4) = ca[p][1]; } }
        if (w == 0) {
            const int rowid = lane >> 3, j = lane & 7, kvh = rowid >> 2, tn = rowid & 3;
            const v4u wv = *(const v4u*)(z + (zr0 + tn) * NIN + 512 + kvh * 64 + 8 * j);
            float x[8]; unpack8(wv, x);
            k_norm_rope(x, j, P.gk, P.rope + (2048 + tn) * 64);
            *(LAS v4u*)(lds + MX_KS + ((kvh * KROWS + 128 + tn) * KST + 8 * j) * 2) = pack8(x);
            float* kp = P.out + OFF_KS + ((size_t)(sq * 128 + 124 + tn) * 2 + kvh) * 64 + 8 * j;
            *(f32x4*)kp = (f32x4){x[0], x[1], x[2], x[3]}; *(f32x4*)(kp + 4) = (f32x4){x[4], x[5], x[6], x[7]};
        } else if (w == 1) {
#pragma unroll
            for (int p = 0; p < 3; ++p) { const int id = p * 64 + lane, rowid = id >> 3, j = id & 7, kvh = rowid / 12, r = 132 + rowid % 12;
                *(LAS v4u*)(lds + MX_KS + ((kvh * KROWS + r) * KST + 8 * j) * 2) = (v4u){0u, 0u, 0u, 0u}; }
        }
    }
    for (int p = 0; p < 2; ++p) {
        const int id = p * 512 + tid;
        if (id < 576) {
            const int dc = id & 7, kg = (id >> 3) % 36, kvh = id / 288; float v[4][8];
#pragma unroll
            for (int kk = 0; kk < 4; ++kk) { const int r = 4 * kg + kk;
                if (r < 128) { const float* cp = P.cache_v + ((size_t)(sq * 128 + r) * 2 + kvh) * 64 + 8 * dc; const f32x4 a = *(const f32x4*)cp, c = *(const f32x4*)(cp + 4);
                    v[kk][0] = a[0]; v[kk][1] = a[1]; v[kk][2] = a[2]; v[kk][3] = a[3]; v[kk][4] = c[0]; v[kk][5] = c[1]; v[kk][6] = c[2]; v[kk][7] = c[3]; }
                else if (r < 132) { const v4u wv = *(const v4u*)(z + (zr0 + (r - 128)) * NIN + 640 + kvh * 64 + 8 * dc); unpack8(wv, v[kk]); }
                else {
#pragma unroll
                    for (int e = 0; e < 8; ++e) v[kk][e] = 0.f; }
                if (r >= 4 && r < 132) { float* vp = P.out + OFF_VS + ((size_t)(sq * 128 + (r - 4)) * 2 + kvh) * 64 + 8 * dc;
                    *(f32x4*)vp = (f32x4){v[kk][0], v[kk][1], v[kk][2], v[kk][3]}; *(f32x4*)(vp + 4) = (f32x4){v[kk][4], v[kk][5], v[kk][6], v[kk][7]}; } }
#pragma unroll
            for (int e = 0; e < 8; ++e) { v2u o; o.x = pk2(v[0][e], v[1][e]); o.y = pk2(v[2][e], v[3][e]); *(LAS v2u*)(lds + MX_VT + ((kvh * 64 + 8 * dc + e) * VST + 4 * kg) * 2) = o; }
        }
    }
    __syncthreads();
    f32x4 O[4]; LAS float* red = (LAS float*)(lds + MX_RED);
    const int hh = fr >> 2, t = fr & 3, head = (w & 1) * 4 + hh;
    if (w < 2) {
        s16x8 q0, q1;
        q_frag(z + (zr0 + t) * NIN + head * 64, P.gq, P.rope + (2048 + t) * 64, fq, q0, q1);
        attn_strip((const LAS bf16*)(lds + MX_KS) + (w * KROWS) * KST, (const LAS bf16*)(lds + MX_VT) + w * 64 * VST, q0, q1, t, 0, P.sinks[head] * LOG2E, fr, fq, O);
        float q = 0.f;
#pragma unroll
        for (int dt = 0; dt < 4; ++dt) q += (O[dt][0] * O[dt][0] + O[dt][1] * O[dt][1]) + (O[dt][2] * O[dt][2] + O[dt][3] * O[dt][3]);
        q += __shfl_xor(q, 16); q += __shfl_xor(q, 32);
        if (fq == 0) red[t * 8 + head] = q;
    }
    __syncthreads();
    if (w < 2) {
        const LAS f32x4* rr = (const LAS f32x4*)(red + t * 8); const f32x4 a = rr[0], c = rr[1];
        const float rstd = rsqrtf(((a[0] + a[1]) + (a[2] + a[3]) + (c[0] + c[1]) + (c[2] + c[3])) * (1.0f / 512.0f) + EPS);
        bf16* mp = P.mixed + (zr0 + t) * D + head * 64 + 4 * fq;
#pragma unroll
        for (int dt = 0; dt < 4; ++dt) { v2u o; o.x = pk2(O[dt][0] * rstd, O[dt][1] * rstd); o.y = pk2(O[dt][2] * rstd, O[dt][3] * rstd); *(v2u*)(mp + 16 * dt) = o; }
    } else if (w < 6) {
        const int tt = w - 2; const size_t row = zr0 + tt; const float* st = P.state_conv + (size_t)sq * 2 * 512;
        float* uo = tt >= 2 ? P.out + OFF_CS + (size_t)(sq * 2 + (tt - 2)) * 512 : nullptr;
        conv_token(z, P.mixed, P.convw, row, tt >= 1 ? 1 : 2, row - 1, st + 512, tt >= 2 ? 1 : 2, row - 2, st + tt * 512, uo, lane);
    }
    __syncthreads();
}
template <int NA, int NBT, int KSB> struct MiniBatch { s16x8 a[KSB][NA], b[KSB][NBT]; };
template <int NA, int NBT, int KSB>
__device__ __forceinline__ void mb_load(MiniBatch<NA, NBT, KSB>& m, const bf16* ap, const bf16* bp, size_t lda16, size_t ldb16, int k0, int fq) {
#pragma unroll
    for (int s = 0; s < KSB; ++s) {
        const int ko = (KSB >= 2) ? k0 + 64 * (s >> 1) + 16 * fq + 8 * (s & 1) : k0 + 8 * fq;
#pragma unroll
        for (int mt = 0; mt < NA; ++mt) m.a[s][mt] = *(const s16x8*)(ap + mt * lda16 + ko);
#pragma unroll
        for (int nt = 0; nt < NBT; ++nt) m.b[s][nt] = *(const s16x8*)(bp + nt * ldb16 + ko);
    }
}
template <int NA, int NBT, int KSB>
__device__ __forceinline__ void mb_mma(f32x4 (&acc)[NA][NBT], const MiniBatch<NA, NBT, KSB>& m) {
#pragma unroll
    for (int s = 0; s < KSB; ++s)
#pragma unroll
        for (int mt = 0; mt < NA; ++mt)
#pragma unroll
            for (int nt = 0; nt < NBT; ++nt) acc[mt][nt] = __builtin_amdgcn_mfma_f32_16x16x32_bf16(m.b[s][nt], m.a[s][mt], acc[mt][nt], 0, 0, 0);
}
template <int NA, int NBT, int KSB, int NBATCH>
__device__ __forceinline__ void mb_run(f32x4 (&acc)[NA][NBT], const bf16* ap, const bf16* bp, size_t lda16, size_t ldb16, int fq) {
    MiniBatch<NA, NBT, KSB> buf[2];
#pragma unroll
    for (int i = 0; i < 2; ++i) if (i < NBATCH) mb_load(buf[i], ap, bp, lda16, ldb16, i * KSB * 32, fq);
    __builtin_amdgcn_sched_barrier(0);
#pragma unroll
    for (int i = 0; i < NBATCH; ++i) {
        mb_mma(acc, buf[i % 2]);
        __builtin_amdgcn_sched_barrier(0);
        if (i + 2 < NBATCH) { mb_load(buf[i % 2], ap, bp, lda16, ldb16, (i + 2) * KSB * 32, fq); __builtin_amdgcn_sched_barrier(0); }
    }
}
struct MiniEpi { bf16* O; int ldo; const float* rs; const float* ssp; const float* base; float* out; float* sspo; const bf16* pp; };
constexpr int MINI_RED2 = 65536;
template <int MODE, int K>
__device__ __forceinline__ void mini_tile(LAS unsigned char* lds, const bf16* A, const bf16* Bt, int r0, int c0, const MiniEpi& E) {
    const int tid = opaque_tid(), lane = tid & 63, w = __builtin_amdgcn_readfirstlane(tid >> 6), fr = lane & 15, fq = lane >> 4;
    constexpr int ks = K >> 3;
    const bf16* ap = A + (size_t)(r0 + fr) * K + w * ks;
    const bf16* bp = Bt + (size_t)(c0 + fr) * K + w * ks;
    f32x4 acc[2][4];
#pragma unroll
    for (int mt = 0; mt < 2; ++mt)
#pragma unroll
        for (int nt = 0; nt < 4; ++nt) acc[mt][nt] = (f32x4){0.f, 0.f, 0.f, 0.f};
    if constexpr (ks >= 64) mb_run<2, 4, 2, ks / 64>(acc, ap, bp, (size_t)16 * K, (size_t)16 * K, fq);
    else mb_run<2, 4, 1, 1>(acc, ap, bp, (size_t)16 * K, (size_t)16 * K, fq);
    LAS f32x4* red = (LAS f32x4*)lds;
#pragma unroll
    for (int mt = 0; mt < 2; ++mt)
#pragma unroll
        for (int nt = 0; nt < 4; ++nt) red[w * 512 + (mt * 4 + nt) * 64 + lane] = acc[mt][nt];
    __syncthreads();
    f32x4 v = red[tid];
#pragma unroll
    for (int ww = 1; ww < 8; ++ww) v += red[ww * 512 + tid];
    const int mt = tid >> 8, nt = (tid >> 6) & 3, rl = 16 * mt + fr, row = r0 + rl, col = c0 + 16 * nt + 4 * fq; const size_t R = (size_t)MP + row;
    if constexpr (MODE == 0) {
        const float sc = E.rs ? E.rs[R] : 1.0f; v2u o; o.x = pk2(v[0] * sc, v[1] * sc); o.y = pk2(v[2] * sc, v[3] * sc); *(v2u*)(E.O + R * E.ldo + col) = o;
    } else if constexpr (MODE == 1) {
        const float sc = pg8::rstd_from_ssp(E.ssp, (int)R); float t[4];
#pragma unroll
        for (int e = 0; e < 4; ++e) { const float x = fmaxf(v[e] * sc, 0.f); t[e] = x * x; }
        v2u o; o.x = pk2(t[0], t[1]); o.y = pk2(t[2], t[3]); *(v2u*)(E.O + R * E.ldo + col) = o;
    } else if constexpr (MODE == 2 || MODE == 4) {
        if constexpr (MODE == 2) { const f32x4 b = *(const f32x4*)(E.base + (size_t)row * 1024 + col); v += b; }
        else { const v2u bw = *(const v2u*)(E.pp + R * 1024 + col); v += (f32x4){bflo(bw.x), bfhi(bw.x), bflo(bw.y), bfhi(bw.y)}; }
        v2u o; o.x = pk2(v[0], v[1]); o.y = pk2(v[2], v[3]); *(v2u*)(E.O + R * 1024 + col) = o;
        LAS float* red2 = (LAS float*)(lds + MINI_RED2);
        red2[rl * 16 + nt * 4 + fq] = (v[0] * v[0] + v[1] * v[1]) + (v[2] * v[2] + v[3] * v[3]);
        __syncthreads();
        if (tid < 32) { const LAS f32x4* p = (const LAS f32x4*)(red2 + tid * 16); const f32x4 s = (p[0] + p[1]) + (p[2] + p[3]); E.sspo[((size_t)MP + r0 + tid) * 16 + (c0 >> 6)] = (s[0] + s[1]) + (s[2] + s[3]); }
    } else {
        const float sc = pg8::rstd_from_ssp(E.ssp, (int)R); const v2u xw = *(const v2u*)(E.O + R * 1024 + col); const v2u pw = *(const v2u*)(E.pp + R * 1024 + col);
        const float xv[4] = {bflo(xw.x), bfhi(xw.x), bflo(xw.y), bfhi(xw.y)}; const float pv[4] = {bflo(pw.x), bfhi(pw.x), bflo(pw.y), bfhi(pw.y)}; f32x4 y;
#pragma unroll
        for (int e = 0; e < 4; ++e) y[e] = xv[e] + pv[e] / (1.0f + __expf(-v[e] * sc));
        *(f32x4*)(E.out + R * 1024 + col) = y;
    }
    __syncthreads();
}
template <int MODE, int K>
__device__ __forceinline__ void mini_gemm(LAS unsigned char* lds, const bf16* A, const bf16* Bt, int N, const MiniEpi& E, int G) {
    const int ncb = N >> 6, nt = 16 * ncb;
    for (int t = blockIdx.x; t < nt; t += G) mini_tile<MODE, K>(lds, A, Bt, 32 * (t / ncb), 64 * (t % ncb), E);
}

__device__ __forceinline__ void mini_up(LAS unsigned char* lds, const bf16* A, const bf16* Bt, const float* ssp, bf16* U, int G) {
    const int tid_ = opaque_tid(); const int lane = tid_ & 63, w = __builtin_amdgcn_readfirstlane(tid_ >> 6), fr = lane & 15, fq = lane >> 4;
    for (int t = blockIdx.x; t < 256; t += G) {
        const int r0 = 32 * (t >> 4), c0 = 256 * (t & 15) + 32 * w;
        {
            s16x8 av[8];
#pragma unroll
            for (int i = 0; i < 8; ++i) { const int pc = 8 * w + i, mt = pc >> 5, ksx = pc & 31; av[i] = *(const s16x8*)(A + (size_t)(r0 + 16 * mt + fr) * D + 64 * (ksx >> 1) + 16 * fq + 8 * (ksx & 1)); }
#pragma unroll
            for (int i = 0; i < 8; ++i) *(LAS s16x8*)(lds + (8 * w + i) * 1024 + lane * 16) = av[i];
        }
        __syncthreads();
        const bf16* bp = Bt + (size_t)(c0 + fr) * D;
        f32x4 acc[2][2];
#pragma unroll
        for (int mt = 0; mt < 2; ++mt)
#pragma unroll
            for (int nt = 0; nt < 2; ++nt) acc[mt][nt] = (f32x4){0.f, 0.f, 0.f, 0.f};
        s16x8 bb[2][4][2];
#define MU_LOAD(buf, b) do { _Pragma("unroll") for (int s_ = 0; s_ < 4; ++s_) { const int ko = 128 * (b) + 64 * (s_ >> 1) + 16 * fq + 8 * (s_ & 1); \
            _Pragma("unroll") for (int nt = 0; nt < 2; ++nt) bb[buf][s_][nt] = *(const s16x8*)(bp + (size_t)nt * 16 * D + ko); } } while (0)
#define MU_MMA(buf, b) do { _Pragma("unroll") for (int s_ = 0; s_ < 4; ++s_) { const int ksx = 4 * (b) + s_; \
            const s16x8 a0 = *(const LAS s16x8*)(lds + ksx * 1024 + lane * 16), a1 = *(const LAS s16x8*)(lds + (32 + ksx) * 1024 + lane * 16); \
            _Pragma("unroll") for (int nt = 0; nt < 2; ++nt) { acc[0][nt] = __builtin_amdgcn_mfma_f32_16x16x32_bf16(bb[buf][s_][nt], a0, acc[0][nt], 0, 0, 0); acc[1][nt] = __builtin_amdgcn_mfma_f32_16x16x32_bf16(bb[buf][s_][nt], a1, acc[1][nt], 0, 0, 0); } } } while (0)
        MU_LOAD(0, 0); MU_LOAD(1, 1);
        MU_MMA(0, 0); MU_LOAD(0, 2); MU_MMA(1, 1); MU_LOAD(1, 3); MU_MMA(0, 2); MU_LOAD(0, 4); MU_MMA(1, 3); MU_LOAD(1, 5);
        MU_MMA(0, 4); MU_LOAD(0, 6); MU_MMA(1, 5); MU_LOAD(1, 7); MU_MMA(0, 6); MU_MMA(1, 7);
#undef MU_LOAD
#undef MU_MMA
#pragma unroll
        for (int mt = 0; mt < 2; ++mt) { const size_t R = (size_t)MP + r0 + 16 * mt + fr; const float sc = pg8::rstd_from_ssp(ssp, (int)R);
#pragma unroll
            for (int nt = 0; nt < 2; ++nt) { float tv[4];
#pragma unroll
                for (int e = 0; e < 4; ++e) { const float x = fmaxf(acc[mt][nt][e] * sc, 0.f); tv[e] = x * x; }
                v2u o; o.x = pk2(tv[0], tv[1]); o.y = pk2(tv[2], tv[3]); *(v2u*)(U + R * FF + c0 + 16 * nt + 4 * fq) = o; } }
        __syncthreads();
    }
}

constexpr int WS_SCNT_WORD = 3584;
struct P1Order {
    pg8::StaticOrder S; int c; unsigned* cnt;
    __device__ bool next(int i, pg8::Unit& u) const {
        if (c >= 64 && c < 82) { if (i == 0) { u.pm = 64 + (c - 64) / 9; u.pn = (c - 64) % 9; return true; } return S.next(i - 1, u); }
        return S.next(i, u);
    }
    __device__ __forceinline__ void a_ready(const pg8::Unit&) const {}
    __device__ __forceinline__ void done(const pg8::Unit& u) const {
        if (u.pm >= 64) {
            asm volatile("s_waitcnt vmcnt(0)" ::: "memory");
            __builtin_amdgcn_fence(__ATOMIC_RELEASE, "agent");
            asm volatile("s_waitcnt vmcnt(0)" ::: "memory");
            if ((threadIdx.x & 63) == 0) __hip_atomic_fetch_add(cnt, 1u, __ATOMIC_RELAXED, __HIP_MEMORY_SCOPE_AGENT);
        }
    }
};

#define XB_TMO      128
#define XB_XCNT(j)  (256  + 64 * (j))
#define XB_XSUB(j)  (1280 + 64 * (j))
#define XB_XGEN(j)  (2304 + 64 * (j))
#define XB_TOP      3328
#define XB_TOPGEN   3392
#define XCD_BAR_WORDS 3456
#define XB_SPIN_CAP (1u << 18)

__device__ __forceinline__ unsigned xb_ld(unsigned* p)              { return __hip_atomic_load(p, __ATOMIC_RELAXED, __HIP_MEMORY_SCOPE_AGENT); }
__device__ __forceinline__ unsigned xb_add(unsigned* p, unsigned v) { return __hip_atomic_fetch_add(p, v, __ATOMIC_RELAXED, __HIP_MEMORY_SCOPE_AGENT); }
__device__ __forceinline__ unsigned xb_xcc_id() { return (unsigned)__builtin_amdgcn_s_getreg((3 << 11) | 20) & 0xFu; }
#define XB_SPIN(cond, bar) do { unsigned _sp = 0; while (cond) { __builtin_amdgcn_s_sleep(1); \
    if ((++_sp & 255u) == 0u) { if (xb_ld(&(bar)[XB_TMO])) break; if (_sp > XB_SPIN_CAP) { atomicAdd(&(bar)[XB_TMO], 1u); break; } } } } while (0)

struct XcdBarrier {
    unsigned* bar; unsigned x;
    volatile LAS unsigned* st;
};

__device__ __forceinline__ XcdBarrier xcd_barrier_post(unsigned* bar, volatile LAS unsigned* st) {
    XcdBarrier b; b.bar = bar; b.x = xb_xcc_id(); b.st = st;
    if (threadIdx.x == 0) (void)xb_add(&bar[XB_XCNT(b.x)], 1u);
    return b;
}
__device__ __forceinline__ void xcd_barrier_complete(unsigned* bar, unsigned x, unsigned& nloc, unsigned& nx) {
    const unsigned G = gridDim.x * gridDim.y * gridDim.z;
    unsigned sum, cnt, mine, sp = 0u;
    for (;;) {
        sum = 0u; cnt = 0u; mine = 0u;
#pragma unroll
        for (unsigned j = 0; j < 16; ++j) { const unsigned c = xb_ld(&bar[XB_XCNT(j)]); sum += c; cnt += (c > 0u) ? 1u : 0u; mine = (j == x) ? c : mine; }
        if (sum == G) break;
        __builtin_amdgcn_s_sleep(1);
        if ((++sp & 255u) == 0u) { if (xb_ld(&bar[XB_TMO])) break; if (sp > XB_SPIN_CAP) { atomicAdd(&bar[XB_TMO], 1u); break; } }
    }
    nloc = mine > 0u ? mine : 1u; nx = cnt > 0u ? cnt : 1u;
}

__device__ __forceinline__ void xcd_barrier(const XcdBarrier& b) {
    asm volatile("s_waitcnt vmcnt(0)" ::: "memory");
    __syncthreads();
    if (threadIdx.x == 0) {
        unsigned* bar = b.bar;
        __builtin_amdgcn_s_waitcnt(0);
        unsigned nloc = b.st[0], nx = b.st[1];
        if (nloc == 0u) { xcd_barrier_complete(bar, b.x, nloc, nx); b.st[0] = nloc; b.st[1] = nx; }
        const unsigned old = xb_add(&bar[XB_XSUB(b.x)], 1u);
        const unsigned gen = old / nloc;
        if (old + 1u == (gen + 1u) * nloc) {
            __builtin_amdgcn_fence(__ATOMIC_RELEASE, "agent");
            asm volatile("s_waitcnt vmcnt(0)" ::: "memory");
            const unsigned og = xb_add(&bar[XB_TOP], 1u);
            const unsigned tg = og / nx;
            if (og + 1u == (tg + 1u) * nx) xb_add(&bar[XB_TOPGEN], 1u);
            else XB_SPIN(xb_ld(&bar[XB_TOPGEN]) == tg, bar);
            __builtin_amdgcn_fence(__ATOMIC_ACQUIRE, "agent");
            xb_add(&bar[XB_XGEN(b.x)], 1u);
            asm volatile("s_waitcnt vmcnt(0)" ::: "memory");
        } else {
            XB_SPIN(xb_ld(&bar[XB_XGEN(b.x)]) == gen, bar);
            __builtin_amdgcn_fence(__ATOMIC_ACQUIRE, "agent");
            asm volatile("s_waitcnt vmcnt(0)" ::: "memory");
        }
    }
    __syncthreads();
}

#ifndef COOP
#define COOP 1
#endif
constexpr int N_PHASES = 7;
#ifndef DUP_PHASE
#define DUP_PHASE -1
#endif
#ifndef EXTRA_SYNCS
#define EXTRA_SYNCS 0
#endif
#define REPS(k) for (int rep_ = 0; rep_ < ((DUP_PHASE == (k)) ? 2 : 1); ++rep_)
#define DUPSYNC(k) do { if (DUP_PHASE == (k) && rep_ == 0) xcd_barrier(bar); } while (0)

__global__ void __launch_bounds__(NWAVES * 64, 2) fwd_megakernel(Args a) {
    extern __shared__ __attribute__((aligned(16))) unsigned char lds_raw[];
    LAS unsigned char* lds = (LAS unsigned char*)lds_raw;
    const int G = gridDim.x, lo = a.ph_lo, hi = a.ph_hi;
    unsigned char* ws = a.ws;
    volatile LAS unsigned* MISC = (volatile LAS unsigned*)(lds + 131072);
    if (threadIdx.x < 64) MISC[threadIdx.x] = 0u;
    __syncthreads();
    XcdBarrier bar = xcd_barrier_post((unsigned*)(ws + WS_BAR), MISC + 8);
    bf16 *WIN = (bf16*)(ws + WS_WIN), *WO = (bf16*)(ws + WS_WO), *WUP = (bf16*)(ws + WS_WUP), *WDN = (bf16*)(ws + WS_WDN), *WG = (bf16*)(ws + WS_WG), *WP = (bf16*)(ws + WS_WP);
    bf16 *XB = (bf16*)(ws + WS_XB), *PB = (bf16*)(ws + WS_PB), *Z = (bf16*)(ws + WS_Z), *MIXED = (bf16*)(ws + WS_MIXED), *X1B = (bf16*)(ws + WS_X1B), *U = (bf16*)(ws + WS_U), *X2B = (bf16*)(ws + WS_X2B), *PPB = (bf16*)(ws + WS_PPB);
    float *RSTD0 = (float*)(ws + WS_RSTD0), *ROPE = (float*)(ws + WS_ROPE), *SS1 = (float*)(ws + WS_SS1), *SS2 = (float*)(ws + WS_SS2);
#ifndef PH_MASK
#define PH_MASK 0x7f
#endif
#define IN(k) (((PH_MASK >> (k)) & 1) && lo <= (k) && (k) < hi)
#if COOP
#define SEAM(k) do { if (IN(k) && IN((k) + 1)) xcd_barrier(bar); } while (0)
#else
#define SEAM(k) do { } while (0)
#endif
    typedef pg8::StaticOrder SO;
    if (hi > 1000) cg::this_grid().sync();
    for (int i_ = 0; i_ < EXTRA_SYNCS; ++i_) xcd_barrier(bar);
    if (IN(0)) REPS(0) { p0_prologue(a, lds, G); __syncthreads(); DUPSYNC(0); }
    SEAM(0);
    if (IN(1)) REPS(1) {
        unsigned* scnt = (unsigned*)(ws + WS_BAR) + WS_SCNT_WORD;
        pg8::Gemm g{XB, WIN, M, NIN, D}; P1Order S; S.S.init(MP, NIN, G, (int)blockIdx.x); S.c = (G == 256) ? (int)blockIdx.x : -1; S.cnt = scnt;
        pg8::Epi<0> E{Z, NIN, RSTD0, nullptr, nullptr, nullptr, nullptr, nullptr, nullptr};
        if (G == 256) pg8::gemm_phase<pg8::Epi<0>, P1Order, true, true>(lds, g, S, E);
        if ((int)blockIdx.x >= P1_LIGHT0) {
            const int c = (int)blockIdx.x, wv = __builtin_amdgcn_readfirstlane((int)(threadIdx.x >> 6));
            if (c < P1_LIGHT0 + 128) p0_weights(a, lds, 1, (c - P1_LIGHT0) * NWAVES + wv, 128 * NWAVES, 2048);
            else p0_weights(a, lds, 1, 2048 + (c - P1_LIGHT0 - 128) * NWAVES + wv, (G - P1_LIGHT0 - 128) * NWAVES);
        }
        if (G == 256 && (int)blockIdx.x >= P1_LIGHT0) {
            if (threadIdx.x == 0) { unsigned sp = 0; while (__hip_atomic_load(scnt, __ATOMIC_RELAXED, __HIP_MEMORY_SCOPE_AGENT) < 144u) { __builtin_amdgcn_s_sleep(8); if (++sp > (1u << 22)) break; }
                __builtin_amdgcn_fence(__ATOMIC_ACQUIRE, "agent"); asm volatile("s_waitcnt vmcnt(0)" ::: "memory"); }
            __syncthreads();
            MixP P{Z, MIXED, ROPE, a.in[9], a.in[10], a.in[11], a.in[12], a.in[4], a.in[5], a.in[6], a.out};
            for (int u = (int)blockIdx.x - P1_LIGHT0; u < 128; u += G - P1_LIGHT0) mixer_sample_unit(P, lds, u);
        }
        DUPSYNC(1);
    }
    SEAM(1);
    if (IN(2)) REPS(2) {
        MixP P{Z, MIXED, ROPE, a.in[9], a.in[10], a.in[11], a.in[12], a.in[4], a.in[5], a.in[6], a.out};
        for (int u = blockIdx.x; u < 256; u += G) mixer_prompt_unit(P, lds, u & 7, u >> 3, 2);
        DUPSYNC(2);
    }
    SEAM(2);
    if (IN(3)) REPS(3) {
        pg8::Gemm g{MIXED, WO, MP, D, D}; SO S; S.init(MP, D, G, (int)blockIdx.x);
        pg8::Epi<4> E{X1B, D, nullptr, nullptr, nullptr, nullptr, nullptr, SS1, XB};
        pg8::gemm_phase<pg8::Epi<4>, SO, true, true>(lds, g, S, E);
        MiniEpi ME{X1B, D, nullptr, nullptr, nullptr, nullptr, SS1, XB};
        mini_gemm<4, D>(lds, MIXED + (size_t)MP * D, WO, D, ME, G); DUPSYNC(3);
    }
    SEAM(3);
    if (IN(4)) REPS(4) {
        pg8::Gemm g{X1B, WUP, MP, FF, D}; SO S; S.init(MP, FF, G, (int)blockIdx.x);
        pg8::Epi<1> E{U, FF, nullptr, SS1, nullptr, nullptr, nullptr, nullptr, nullptr};
        pg8::gemm_phase<pg8::Epi<1>, SO, true, true>(lds, g, S, E);
        mini_up(lds, X1B + (size_t)MP * D, WUP, SS1, U, G); DUPSYNC(4);
    }
    SEAM(4);
    if (IN(5)) REPS(5) {
        pg8::Gemm g{U, WDN, MP, D, FF}; SO S; S.init(MP, D, G, (int)blockIdx.x);
        pg8::Epi<4> E{X2B, D, nullptr, nullptr, nullptr, nullptr, nullptr, SS2, X1B};
        pg8::gemm_phase<pg8::Epi<4>, SO, true, true>(lds, g, S, E);
        { MiniEpi ME{X2B, D, nullptr, nullptr, nullptr, nullptr, SS2, X1B};
            mini_gemm<4, FF>(lds, U + (size_t)MP * FF, WDN, D, ME, G); }
        DUPSYNC(5);
    }
    SEAM(5);
    if (IN(6) && DUP_PHASE == 6) { pg8::Gemm g{X2B, WG, MP, D, D}; SO S; S.init(MP, D, G, (int)blockIdx.x);
          pg8::Epi<0> E{X1B, D, nullptr, nullptr, nullptr, nullptr, nullptr, nullptr, nullptr};
          pg8::gemm_phase<pg8::Epi<0>, SO, true, true>(lds, g, S, E); xcd_barrier(bar); }
    if (IN(6)) {
        { pg8::Gemm g{PB, WP, MP, D, PLE}; SO S; S.init(MP, D, G, (int)blockIdx.x);
          pg8::Epi<0> E{PPB, D, nullptr, nullptr, nullptr, nullptr, nullptr, nullptr, nullptr};
          pg8::gemm_phase<pg8::Epi<0>, SO, true, true>(lds, g, S, E); }
        { pg8::Gemm g{X2B, WG, MP, D, D}; SO S; S.init(MP, D, G, (int)blockIdx.x);
          pg8::Epi<3> E{X2B, D, nullptr, SS2, nullptr, nullptr, a.out, nullptr, PPB};
          pg8::gemm_phase<pg8::Epi<3>, SO, true, true>(lds, g, S, E); }
        { MiniEpi ME0{PPB, D, nullptr, nullptr, nullptr, nullptr, nullptr, nullptr}; mini_gemm<0, PLE>(lds, PB + (size_t)MP * PLE, WP, D, ME0, G);
          MiniEpi ME3{X2B, D, nullptr, SS2, nullptr, a.out, nullptr, PPB}; mini_gemm<3, D>(lds, X2B + (size_t)MP * D, WG, D, ME3, G); }
    }
#undef IN
#undef SEAM
}

extern "C" void kernel_launch(void* const* d_in, const int* in_sizes, int n_in, void* d_out, int out_size, void* d_ws, size_t ws_size, hipStream_t stream) {
    static int grid = 0;
    if (grid == 0) {
        if (n_in != 22 || in_sizes[0] != MP * D || out_size != (int)OUT_TOTAL || ws_size < WS_END) {
            fprintf(stderr, "kernel_launch: unexpected shapes: n_in %d in0 %d out %d ws %zu (need out %zu ws %zu)\n", n_in, n_in > 0 ? in_sizes[0] : -1, out_size, ws_size, (size_t)OUT_TOTAL, (size_t)WS_END); grid = -1; return; }
        int dev = 0, cus = 0, per_cu = 0;
        hipGetDevice(&dev); hipDeviceGetAttribute(&cus, hipDeviceAttributeMultiprocessorCount, dev);
        if (hipFuncSetAttribute((const void*)fwd_megakernel, hipFuncAttributeMaxDynamicSharedMemorySize, LDS_BYTES) != hipSuccess) { fprintf(stderr, "kernel_launch: hipFuncSetAttribute failed\n"); grid = -1; return; }
        if (hipOccupancyMaxActiveBlocksPerMultiprocessor(&per_cu, (const void*)fwd_megakernel, NWAVES * 64, LDS_BYTES) != hipSuccess || per_cu < 1) { fprintf(stderr, "kernel_launch: occupancy query says %d\n", per_cu); per_cu = 1; }
        (void)hipGetLastError();
        grid = cus;
        if (grid != 256) { fprintf(stderr, "kernel_launch: this build's phase program is laid out for 256 CUs (got %d); nothing launched\n", cus); grid = -1; return; }
        fprintf(stderr, "kernel_launch: cus %d per_cu %d grid %d\n", cus, per_cu, grid);
    }
    if (grid < 0) return;
    Args a{};
    for (int i = 0; i < 22; ++i) a.in[i] = (const float*)d_in[i];
    a.out = (float*)d_out; a.ws = (unsigned char*)d_ws;
#if COOP
    if (hipMemsetAsync((char*)d_ws + WS_BAR, 0, WS_BAR_BYTES, stream) != hipSuccess) { fprintf(stderr, "kernel_launch: memset failed\n"); return; }
    a.ph_lo = 0; a.ph_hi = N_PHASES;
    void* args[] = {&a};
    hipError_t e = hipLaunchCooperativeKernel((const void*)fwd_megakernel, dim3(grid), dim3(NWAVES * 64), args, LDS_BYTES, stream);
    if (e != hipSuccess) fprintf(stderr, "kernel_launch: cooperative launch failed: %s (grid %d)\n", hipGetErrorString(e), grid);
#else
    for (int p = 0; p < N_PHASES; ++p) { a.ph_lo = p; a.ph_hi = p + 1; hipLaunchKernelGGL(fwd_megakernel, dim3(grid), dim3(NWAVES * 64), LDS_BYTES, stream, a); }
#endif
}
```

```cpp
#include <hip/hip_runtime.h>
#include <hip/hip_cooperative_groups.h>
#include <cstdio>
#include <cstdint>
namespace cg = cooperative_groups;
__device__ __forceinline__ int opaque_tid() { int t = (int)threadIdx.x; asm volatile("" : "+v"(t)); return t; }
__device__ __forceinline__ int opaque_bid() { return (int)blockIdx.x; }
namespace pg8 {
#define PG8_LAS __attribute__((address_space(3)))
typedef unsigned short bf16_t;
typedef short bf16x8 __attribute__((ext_vector_type(8)));
typedef float f32x4 __attribute__((ext_vector_type(4)));
typedef unsigned u32x4 __attribute__((ext_vector_type(4)));
constexpr int BM = 256, BK = 64, HALF = 128, HTB = HALF * BK * 2  , STAGE_BYTES = 8 * HTB, NXCD = 8, WGM = 8;

__host__ __device__ __forceinline__ int lds_byte(int r, int c) { const int st = (r >> 4) * 2 + (c >> 5), rr = r & 15, cc = c & 31, ob = rr * 64 + cc * 2; return st * 1024 + (ob ^ (((ob >> 9) & 1) << 5)); }
__host__ __device__ __forceinline__ void stage_rc(int b, int& R, int& C) { const int st = b / 1024, sb = b % 1024, swz = sb ^ (((sb >> 9) & 1) << 5); R = (st >> 1) * 16 + swz / 64; C = (st & 1) * 32 + (swz % 64) / 2; }
__host__ __device__ __forceinline__ int perm32(int rho) { const int n = rho >> 4, i = rho & 15; return 8 * (i >> 2) + 4 * n + (i & 3); }

struct Unit { int pm, pn; };
struct Gemm { const bf16_t* A; const bf16_t* Bt; int M, N, K; };

struct StaticOrder {
    int nM, nN, nwg, G, c;
    __host__ __device__ void init(int M, int N, int G_, int c_) { nM = M / BM; nN = N / BM; nwg = nM * nN; G = G_; c = c_; }
    __host__ __device__ bool next(int i, Unit& u) const {
        const long L = (long)i * G + c; if (L >= nwg) return false;
        int wgid = (int)L; { const int q = nwg / NXCD, r = nwg % NXCD, xcd = wgid % NXCD, off = wgid / NXCD; wgid = (xcd < r ? xcd * (q + 1) : r * (q + 1) + (xcd - r) * q) + off; }
        const int nig = WGM * nN, gid = wgid / nig, fm = gid * WGM, gsz = (nM - fm) < WGM ? (nM - fm) : WGM;
        u.pm = fm + ((wgid % nig) % gsz); u.pn = (wgid % nig) / gsz; return true;
    }
    __device__ __forceinline__ void a_ready(const Unit&) const {}
    __device__ __forceinline__ void done(const Unit&) const {}
};

__device__ __forceinline__ unsigned cvt_pk_bf16(float lo, float hi) { unsigned r; asm volatile("v_cvt_pk_bf16_f32 %0, %1, %2" : "=v"(r) : "v"(lo), "v"(hi)); return r; }
typedef float f32x2 __attribute__((ext_vector_type(2)));
constexpr float RMS_EPS = 1e-6f;
__device__ __forceinline__ float rstd_from_ssp(const float* ssp, int row) {
    const f32x4* p = (const f32x4*)(ssp + (size_t)row * 16); const f32x4 s = (p[0] + p[1]) + (p[2] + p[3]);
    return rsqrtf(((s[0] + s[1]) + (s[2] + s[3])) * (1.0f / 1024.0f) + RMS_EPS);
}
__device__ __forceinline__ void unpack_bf16x8(const u32x4 w, f32x4& lo, f32x4& hi) {
    lo = (f32x4){__uint_as_float(w.x << 16), __uint_as_float(w.x & 0xffff0000u), __uint_as_float(w.y << 16), __uint_as_float(w.y & 0xffff0000u)};
    hi = (f32x4){__uint_as_float(w.z << 16), __uint_as_float(w.z & 0xffff0000u), __uint_as_float(w.w << 16), __uint_as_float(w.w & 0xffff0000u)};
}
template <int MODE> struct Epi {
    static constexpr bool PERM = true, AFTER_DRAIN = false;
    bf16_t* O; int ldo; const float* rs; const float* ssp;
    const float* base0; const float* base1; float* out; float* sspo; const bf16_t* pp;
    __device__ __forceinline__ void operator()(const f32x4 (&acc)[2][2][4][2], const Unit& u, int wr, int wc, int fr, int fq) const {
        const int row0 = u.pm * BM + wr * 64 + fr, col0 = u.pn * BM + wc * 32 + 8 * fq;
        float sc[2][4];
        if constexpr (MODE == 0) {
#pragma unroll
            for (int ai = 0; ai < 2; ++ai)
#pragma unroll
                for (int m = 0; m < 4; ++m) sc[ai][m] = rs ? rs[row0 + ai * HALF + m * 16] : 1.0f;
        } else if constexpr (MODE == 1 || MODE == 3) {
            f32x4 pz[2][4];
#pragma unroll
            for (int ai = 0; ai < 2; ++ai)
#pragma unroll
                for (int m = 0; m < 4; ++m) pz[ai][m] = *(const f32x4*)(ssp + (size_t)(row0 + ai * HALF + m * 16) * 16 + 4 * fq);
#pragma unroll
            for (int ai = 0; ai < 2; ++ai)
#pragma unroll
                for (int m = 0; m < 4; ++m) { float t = (pz[ai][m][0] + pz[ai][m][1]) + (pz[ai][m][2] + pz[ai][m][3]); t += __shfl_xor(t, 16); t += __shfl_xor(t, 32);
                    sc[ai][m] = rsqrtf(t * (1.0f / 1024.0f) + RMS_EPS); }
        }
        if constexpr (MODE == 0 || MODE == 1) {
#pragma unroll
            for (int ai = 0; ai < 2; ++ai)
#pragma unroll
                for (int m = 0; m < 4; ++m) {
                    bf16_t* rowp = O + (size_t)(row0 + ai * HALF + m * 16) * ldo + col0; const float s1 = sc[ai][m];
#pragma unroll
                    for (int bj = 0; bj < 2; ++bj) { f32x4 v0 = acc[ai][bj][m][0] * s1, v1 = acc[ai][bj][m][1] * s1;
                        if constexpr (MODE == 1) {
#pragma unroll
                            for (int e = 0; e < 4; ++e) { const float a = fmaxf(v0[e], 0.f), b = fmaxf(v1[e], 0.f); v0[e] = a * a; v1[e] = b * b; } }
                        u32x4 w; w.x = cvt_pk_bf16(v0[0], v0[1]); w.y = cvt_pk_bf16(v0[2], v0[3]); w.z = cvt_pk_bf16(v1[0], v1[1]); w.w = cvt_pk_bf16(v1[2], v1[3]);
                        *(u32x4*)(rowp + bj * HALF) = w; }
                }
        } else if constexpr (MODE == 4) {
            u32x4 bw[2][4][2];
#pragma unroll
            for (int ai = 0; ai < 2; ++ai)
#pragma unroll
                for (int m = 0; m < 4; ++m)
#pragma unroll
                    for (int bj = 0; bj < 2; ++bj) bw[ai][m][bj] = *(const u32x4*)(pp + (size_t)(row0 + ai * HALF + m * 16) * 1024 + col0 + bj * HALF);
#pragma unroll
            for (int ai = 0; ai < 2; ++ai)
#pragma unroll
                for (int m = 0; m < 4; ++m) {
                    const int row = row0 + ai * HALF + m * 16; bf16_t* xp = O + (size_t)row * 1024 + col0; float q = 0.f;
#pragma unroll
                    for (int bj = 0; bj < 2; ++bj) { f32x4 b0, b1; unpack_bf16x8(bw[ai][m][bj], b0, b1);
                        const f32x4 v0 = acc[ai][bj][m][0] + b0, v1 = acc[ai][bj][m][1] + b1;
                        q += (v0[0] * v0[0] + v0[1] * v0[1]) + (v0[2] * v0[2] + v0[3] * v0[3]) + (v1[0] * v1[0] + v1[1] * v1[1]) + (v1[2] * v1[2] + v1[3] * v1[3]);
                        u32x4 w; w.x = cvt_pk_bf16(v0[0], v0[1]); w.y = cvt_pk_bf16(v0[2], v0[3]); w.z = cvt_pk_bf16(v1[0], v1[1]); w.w = cvt_pk_bf16(v1[2], v1[3]);
                        *(u32x4*)(xp + bj * HALF) = w; }
                    q += __shfl_xor(q, 16); q += __shfl_xor(q, 32);
                    if (fq == 0) sspo[(size_t)row * 16 + u.pn * 4 + wc] = q;
                }
        } else {
            u32x4 xw[4][2][2], pw[4][2][2];
#define EPI3_LOAD(b) do { _Pragma("unroll") for (int r = 0; r < 2; ++r) { const int row = row0 + ((b) >> 1) * HALF + (((b) & 1) * 2 + r) * 16; \
                _Pragma("unroll") for (int bj = 0; bj < 2; ++bj) { xw[b][r][bj] = *(const u32x4*)(O + (size_t)row * 1024 + col0 + bj * HALF); pw[b][r][bj] = *(const u32x4*)(pp + (size_t)row * 1024 + col0 + bj * HALF); } } } while (0)
#define EPI3_DO(b) do { _Pragma("unroll") for (int r = 0; r < 2; ++r) { const int ai = (b) >> 1, m = ((b) & 1) * 2 + r; const int row = row0 + ai * HALF + m * 16; float* op = out + (size_t)row * 1024 + col0; const float s1 = sc[ai][m]; \
                _Pragma("unroll") for (int bj = 0; bj < 2; ++bj) { f32x4 x0, x1, p0, p1; unpack_bf16x8(xw[b][r][bj], x0, x1); unpack_bf16x8(pw[b][r][bj], p0, p1); f32x4 v0, v1; \
                    _Pragma("unroll") for (int e = 0; e < 4; ++e) { const float g0 = 1.0f / (1.0f + __expf(-acc[ai][bj][m][0][e] * s1)), g1 = 1.0f / (1.0f + __expf(-acc[ai][bj][m][1][e] * s1)); v0[e] = x0[e] + g0 * p0[e]; v1[e] = x1[e] + g1 * p1[e]; } \
                    __builtin_nontemporal_store(v0, (f32x4*)(op + bj * HALF)); __builtin_nontemporal_store(v1, (f32x4*)(op + bj * HALF + 4)); } } } while (0)
            EPI3_LOAD(0); EPI3_LOAD(1); EPI3_DO(0); EPI3_LOAD(2); EPI3_DO(1); EPI3_LOAD(3); EPI3_DO(2); EPI3_DO(3);
#undef EPI3_LOAD
#undef EPI3_DO
        }
    }
};

template <class Epi, class Sched, bool ALIGN_EPI = false, bool SP2 = false>
__device__ __forceinline__ void gemm_phase(PG8_LAS unsigned char* lds, const Gemm g, const Sched& S, const Epi& E) {
    const int tid = opaque_tid(), wid = __builtin_amdgcn_readfirstlane(tid >> 6), lane = tid & 63, wr = wid >> 2, wc = wid & 3, fr = lane & 15, fq = lane >> 4;
    const int K = g.K, nt = K / BK;
    unsigned voffA[2], voffB[2];
#pragma unroll
    for (int i = 0; i < 2; ++i) { int R, C; stage_rc(tid * 16 + i * 8192, R, C); const int Rb = Epi::PERM ? ((R & ~31) + perm32(R & 31)) : R;
        voffA[i] = (unsigned)(R * K + C) * 2u; voffB[i] = (unsigned)(Rb * K + C) * 2u; }
    const size_t kstep = (size_t)(BK * 2);
    const size_t hstep = (size_t)HALF * K * 2;
    const size_t tstep = 2 * hstep;
    const unsigned ldsw = (unsigned)wid * 1024u;
    const int aoff = lds_byte(wr * 64 + fr, fq * 8), boff = lds_byte(wc * 32 + fr, fq * 8);
#define PG8_SA(b, h) (((b) * 2 + (h)) * HTB)
#define PG8_SB(b, h) ((4 + (b) * 2 + (h)) * HTB)
#define PG8_STAGE(bufoff, gbase, voff) do { _Pragma("unroll") for (int _i = 0; _i < 2; ++_i) \
        __builtin_amdgcn_global_load_lds((const unsigned*)((const char*)(gbase) + (voff)[_i]), (PG8_LAS unsigned*)(lds + (bufoff) + ldsw + _i * 8192), 16, 0, 0); } while (0)
#define PG8_LDA(dst, b, h) do { _Pragma("unroll") for (int m = 0; m < 4; ++m) _Pragma("unroll") for (int k = 0; k < 2; ++k) dst[m][k] = *(const PG8_LAS bf16x8*)(lds + PG8_SA(b, h) + aoff + m * 2048 + k * 1024); } while (0)
#define PG8_LDB(dst, b, h) do { _Pragma("unroll") for (int n = 0; n < 2; ++n) _Pragma("unroll") for (int k = 0; k < 2; ++k) dst[n][k] = *(const PG8_LAS bf16x8*)(lds + PG8_SB(b, h) + boff + n * 2048 + k * 1024); } while (0)
#define PG8_MMA(ai, bj, At, Bt) do { __builtin_amdgcn_s_setprio(1); _Pragma("unroll") for (int m = 0; m < 4; ++m) _Pragma("unroll") for (int n = 0; n < 2; ++n) _Pragma("unroll") for (int k = 0; k < 2; ++k) \
        acc[ai][bj][m][n] = __builtin_amdgcn_mfma_f32_16x16x32_bf16(Bt[n][k], At[m][k], acc[ai][bj][m][n], 0, 0, 0); __builtin_amdgcn_s_setprio(0); } while (0)
#define PG8_WAIT_V(n) asm volatile("s_waitcnt vmcnt(" #n ")" ::: "memory")
#define PG8_WAIT_L(n) asm volatile("s_waitcnt lgkmcnt(" #n ")" ::: "memory")
#define PG8_BAR __builtin_amdgcn_s_barrier()
#define PG8_SCHED __builtin_amdgcn_sched_barrier(0)
    Unit cur, nxt; int ui = 0;
    if (!S.next(0, cur)) return;
    f32x4 acc[2][2][4][2];
#pragma unroll
    for (int a = 0; a < 2; ++a)
#pragma unroll
        for (int b = 0; b < 2; ++b)
#pragma unroll
            for (int m = 0; m < 4; ++m)
#pragma unroll
                for (int n = 0; n < 2; ++n) acc[a][b][m][n] = (f32x4){0.f, 0.f, 0.f, 0.f};
    bf16x8 At[4][2], B0[2][2], B1[2][2];
    const char* cA = (const char*)g.A + (size_t)cur.pm * tstep; const char* cB = (const char*)g.Bt + (size_t)cur.pn * tstep;
    S.a_ready(cur);
    if constexpr (SP2) {
        PG8_STAGE(PG8_SB(0, 0), cB, voffB); PG8_STAGE(PG8_SB(0, 1), cB + hstep, voffB); PG8_STAGE(PG8_SA(0, 0), cA, voffA); PG8_STAGE(PG8_SA(0, 1), cA + hstep, voffA);
        if (wr == 1) PG8_BAR;
        PG8_WAIT_V(2); PG8_BAR;
        PG8_STAGE(PG8_SB(1, 0), cB + kstep, voffB); PG8_STAGE(PG8_SA(1, 0), cA + kstep, voffA); PG8_STAGE(PG8_SB(1, 1), cB + hstep + kstep, voffB);
        PG8_WAIT_V(6); PG8_BAR;
    } else {
        PG8_STAGE(PG8_SB(0, 0), cB, voffB); PG8_STAGE(PG8_SA(0, 0), cA, voffA); PG8_STAGE(PG8_SB(0, 1), cB + hstep, voffB); PG8_STAGE(PG8_SA(0, 1), cA + hstep, voffA);
        if (wr == 1) PG8_BAR;
        PG8_WAIT_V(4); PG8_BAR;
        PG8_STAGE(PG8_SB(1, 0), cB + kstep, voffB); PG8_STAGE(PG8_SA(1, 0), cA + kstep, voffA); PG8_STAGE(PG8_SB(1, 1), cB + hstep + kstep, voffB);
        PG8_WAIT_V(6); PG8_BAR;
    }
    for (;;) {
        const bool has_next = S.next(ui + 1, nxt);
        const char* nA = has_next ? (const char*)g.A + (size_t)nxt.pm * tstep : cA; const char* nB = has_next ? (const char*)g.Bt + (size_t)nxt.pn * tstep : cB;
        for (int t = 0; t < nt; t += 2) {
            const bool last = (t == nt - 2);
            const char* a1 = cA + (size_t)(t + 1) * kstep;
            const char* a2 = last ? nA : cA + (size_t)(t + 2) * kstep; const char* b2 = last ? nB : cB + (size_t)(t + 2) * kstep;
            const char* a3 = a2 + kstep; const char* b3 = b2 + kstep;
            if (last && has_next) S.a_ready(nxt);
            if constexpr (SP2) {
            PG8_LDB(B0, 0, 0); PG8_LDB(B1, 0, 1); PG8_SCHED; PG8_LDA(At, 0, 0); PG8_STAGE(PG8_SA(1, 1), a1 + hstep, voffA);
            PG8_WAIT_V(8); PG8_WAIT_L(0); PG8_BAR; PG8_MMA(0, 0, At, B0); PG8_MMA(0, 1, At, B1); PG8_BAR; PG8_SCHED;
            PG8_LDA(At, 0, 1); PG8_STAGE(PG8_SB(0, 0), b2, voffB); PG8_STAGE(PG8_SB(0, 1), b2 + hstep, voffB); PG8_STAGE(PG8_SA(0, 0), a2, voffA);
            PG8_WAIT_V(8); PG8_WAIT_L(0); PG8_BAR; PG8_MMA(1, 0, At, B0); PG8_MMA(1, 1, At, B1); PG8_BAR; PG8_SCHED;
            PG8_LDB(B0, 1, 0); PG8_LDB(B1, 1, 1); PG8_SCHED; PG8_LDA(At, 1, 0); PG8_STAGE(PG8_SA(0, 1), a2 + hstep, voffA);
            PG8_WAIT_V(8); PG8_WAIT_L(0); PG8_BAR; PG8_MMA(0, 0, At, B0); PG8_MMA(0, 1, At, B1); PG8_BAR; PG8_SCHED;
            PG8_LDA(At, 1, 1); PG8_STAGE(PG8_SB(1, 0), b3, voffB); PG8_STAGE(PG8_SB(1, 1), b3 + hstep, voffB); PG8_STAGE(PG8_SA(1, 0), a3, voffA);
            PG8_WAIT_V(8); PG8_WAIT_L(0); PG8_BAR; PG8_MMA(1, 0, At, B0); PG8_MMA(1, 1, At, B1); PG8_BAR; PG8_SCHED;
            } else {
            PG8_LDB(B0, 0, 0); PG8_SCHED; PG8_LDA(At, 0, 0); PG8_STAGE(PG8_SA(1, 1), a1 + hstep, voffA);
            PG8_WAIT_L(8); PG8_BAR; PG8_WAIT_L(0); PG8_MMA(0, 0, At, B0); PG8_BAR; PG8_SCHED;
            PG8_LDB(B1, 0, 1); PG8_STAGE(PG8_SB(0, 0), b2, voffB);
            PG8_BAR; PG8_WAIT_L(0); PG8_MMA(0, 1, At, B1); PG8_BAR;
            PG8_LDA(At, 0, 1); PG8_STAGE(PG8_SA(0, 0), a2, voffA);
            PG8_BAR; PG8_WAIT_L(0); PG8_MMA(1, 0, At, B0); PG8_BAR; PG8_SCHED;
            PG8_STAGE(PG8_SB(0, 1), b2 + hstep, voffB);
            PG8_WAIT_V(6); PG8_BAR; PG8_MMA(1, 1, At, B1); PG8_BAR;
            PG8_LDB(B0, 1, 0); PG8_SCHED; PG8_LDA(At, 1, 0); PG8_STAGE(PG8_SA(0, 1), a2 + hstep, voffA);
            PG8_WAIT_L(8); PG8_BAR; PG8_WAIT_L(0); PG8_MMA(0, 0, At, B0); PG8_BAR; PG8_SCHED;
            PG8_LDB(B1, 1, 1); PG8_STAGE(PG8_SB(1, 0), b3, voffB);
            PG8_BAR; PG8_WAIT_L(0); PG8_MMA(0, 1, At, B1); PG8_BAR;
            PG8_LDA(At, 1, 1); PG8_STAGE(PG8_SA(1, 0), a3, voffA);
            PG8_BAR; PG8_WAIT_L(0); PG8_MMA(1, 0, At, B0); PG8_BAR; PG8_SCHED;
            PG8_STAGE(PG8_SB(1, 1), b3 + hstep, voffB);
            PG8_WAIT_V(6); PG8_BAR; PG8_MMA(1, 1, At, B1); PG8_BAR;
            }
        }
        if constexpr (ALIGN_EPI) { if (wr == 0) PG8_BAR; }
        if constexpr (!Epi::AFTER_DRAIN) { E(acc, cur, wr, wc, fr, fq); S.done(cur); }
        if (!has_next) break;
#pragma unroll
        for (int a = 0; a < 2; ++a)
#pragma unroll
            for (int b = 0; b < 2; ++b)
#pragma unroll
                for (int m = 0; m < 4; ++m)
#pragma unroll
                    for (int n = 0; n < 2; ++n) acc[a][b][m][n] = (f32x4){0.f, 0.f, 0.f, 0.f};
        cur = nxt; cA = nA; cB = nB; ++ui;
        if constexpr (ALIGN_EPI) { if (wr == 1) PG8_BAR; }
    }
    PG8_WAIT_V(0);
    if constexpr (!ALIGN_EPI) { if (wr == 0) PG8_BAR; }
    PG8_BAR;
    if constexpr (Epi::AFTER_DRAIN) { E.fused(acc, cur, wr, wc, fr, fq, lds, wid, lane); S.done(cur); }
#undef PG8_SA
#undef PG8_SB
#undef PG8_STAGE
#undef PG8_LDA
#undef PG8_LDB
#undef PG8_MMA
#undef PG8_WAIT_V
#undef PG8_WAIT_L
#undef PG8_BAR
#undef PG8_SCHED
}
}
#define LAS __attribute__((address_space(3)))
typedef unsigned short bf16;
typedef unsigned v4u __attribute__((ext_vector_type(4)));
typedef unsigned v2u __attribute__((ext_vector_type(2)));
typedef float f32x4 __attribute__((ext_vector_type(4)));
typedef short s16x8 __attribute__((ext_vector_type(8)));
typedef short s16x4 __attribute__((ext_vector_type(4)));

constexpr int D = 1024, MP = 16384, MS = 512, M = MP + MS, NIN = 2304, FF = 4096, PLE = 256, SEQ = 2048, NWAVES = 8;
constexpr float EPS = 1e-6f;
constexpr float LOG2E = 1.4426950408889634f;
constexpr size_t MiB = 1u << 20;
constexpr size_t WS_RSTD0 = 0, WS_BAR = 96 * 1024, WS_BAR_BYTES = 16 * 1024, WS_ROPE = 128 * 1024, WS_SS1 = 1 * MiB, WS_SS2 = 3 * MiB;
constexpr size_t WS_WIN = 6 * MiB, WS_WO = WS_WIN + (size_t)NIN * D * 2, WS_WUP = WS_WO + 2 * MiB, WS_WDN = WS_WUP + 8 * MiB, WS_WG = WS_WDN + 8 * MiB, WS_WP = WS_WG + 2 * MiB;
constexpr size_t WS_PB = 31 * MiB, WS_U = 40 * MiB, WS_Z = 40 * MiB, WS_XB = 115 * MiB, WS_PPB = 40 * MiB, WS_X1B = 172 * MiB, WS_MIXED = 205 * MiB, WS_X2B = 205 * MiB, WS_END = 238 * MiB;
static_assert(WS_WP + (size_t)D * PLE * 2 <= WS_PB && WS_PB + (size_t)M * PLE * 2 <= WS_U && WS_Z + (size_t)M * NIN * 2 <= WS_XB && WS_XB + (size_t)M * D * 2 <= WS_X1B && WS_U + (size_t)M * FF * 2 <= WS_X1B && WS_X1B + (size_t)M * D * 2 <= WS_MIXED && WS_MIXED + (size_t)M * D * 2 <= WS_END, "ws map");
static_assert(WS_ROPE + 2052 * 64 * 4 <= WS_SS1 && WS_SS1 + (size_t)M * 64 <= WS_SS2 && WS_SS2 + (size_t)M * 64 <= WS_WIN, "ws map (small)");
constexpr size_t OFF_YP = 0, OFF_YS = (size_t)MP * D, OFF_KP = OFF_YS + (size_t)MS * D, OFF_VP = OFF_KP + 8 * 128 * 128, OFF_CP = OFF_VP + 8 * 128 * 128,
                 OFF_KS = OFF_CP + 8 * 2 * 512, OFF_VS = OFF_KS + 128 * 128 * 128, OFF_CS = OFF_VS + 128 * 128 * 128, OUT_TOTAL = OFF_CS + 128 * 2 * 512;
constexpr int LDS_BYTES = 147456;

#define LDS_WAIT() asm volatile("s_waitcnt lgkmcnt(0)" ::: "memory")
__device__ __forceinline__ unsigned pk2(float lo, float hi) { return pg8::cvt_pk_bf16(lo, hi); }
__device__ __forceinline__ float bflo(unsigned w) { return __uint_as_float(w << 16); }
__device__ __forceinline__ float bfhi(unsigned w) { return __uint_as_float(w & 0xffff0000u); }
__device__ __forceinline__ void unpack8(const v4u w, float (&x)[8]) { x[0] = bflo(w.x); x[1] = bfhi(w.x); x[2] = bflo(w.y); x[3] = bfhi(w.y); x[4] = bflo(w.z); x[5] = bfhi(w.z); x[6] = bflo(w.w); x[7] = bfhi(w.w); }
__device__ __forceinline__ v4u pack8(const float (&x)[8]) { v4u o; o.x = pk2(x[0], x[1]); o.y = pk2(x[2], x[3]); o.z = pk2(x[4], x[5]); o.w = pk2(x[6], x[7]); return o; }
__device__ __forceinline__ float wave_sum(float v) {
#pragma unroll
    for (int o = 1; o < 64; o <<= 1) v += __shfl_xor(v, o);
    return v;
}

struct Args { const float* in[22]; float* out; unsigned char* ws; int ph_lo, ph_hi; };

__device__ __forceinline__ void p0_transpose_item(const float* W, int K, int N, bf16* WT, const float* g, LAS float* scr, int k0, int n0, int lane) {
    const int r8 = lane >> 3, c4 = (lane & 7) * 4;
    f32x4 v[8];
#pragma unroll
    for (int i = 0; i < 8; ++i) v[i] = __builtin_nontemporal_load((const f32x4*)(W + (size_t)(k0 + 8 * i + r8) * N + n0 + c4));
#pragma unroll
    for (int i = 0; i < 8; ++i) { const int kk = 8 * i + r8; const float gv = g ? g[kk] : 1.0f; LAS float* d = scr + kk * 33 + c4;
        d[0] = v[i][0] * gv; d[1] = v[i][1] * gv; d[2] = v[i][2] * gv; d[3] = v[i][3] * gv; }
    LDS_WAIT(); asm volatile("" ::: "memory");
    const int c = lane & 7;
#pragma unroll
    for (int j = 0; j < 4; ++j) { const int n = (lane >> 3) + 8 * j; const LAS float* s = scr + (8 * c) * 33 + n;
        v4u o; o.x = pk2(s[0 * 33], s[1 * 33]); o.y = pk2(s[2 * 33], s[3 * 33]); o.z = pk2(s[4 * 33], s[5 * 33]); o.w = pk2(s[6 * 33], s[7 * 33]);
        *(v4u*)(WT + (size_t)(n0 + n) * K + k0 + 8 * c) = o; }
    LDS_WAIT(); asm volatile("" ::: "memory");
}
constexpr int P1_LIGHT0 = 82;
__device__ __forceinline__ void p0_weights(const Args& a, LAS unsigned char* lds, int set, int gw, int NGW, int it_end = 1 << 30) {
    const int lane = opaque_tid() & 63, wave = __builtin_amdgcn_readfirstlane(opaque_tid() >> 6);
    unsigned char* ws = a.ws;
    LAS float* scr = (LAS float*)(lds + wave * 16384);
    constexpr int I_IN = 16 * (NIN / 32), I_O = 16 * 32, I_UP = 16 * (FF / 32), I_DN = 64 * 32, I_G = 16 * 32, I_P = 4 * 32;
    const int nitems = set == 0 ? I_IN + I_O + I_P : I_UP + I_DN + I_G;
    const int itend = it_end < nitems ? it_end : nitems;
    for (int it = gw; it < itend; it += NGW) {
        int r = it; const float* W; const float* g; bf16* WT; int K, N;
        if (set == 0) {
            if (r < I_IN) { W = a.in[8]; g = a.in[7]; WT = (bf16*)(ws + WS_WIN); K = D; N = NIN; }
            else if ((r -= I_IN) < I_O) { W = a.in[15]; g = nullptr; WT = (bf16*)(ws + WS_WO); K = D; N = D; }
            else { r -= I_O; W = a.in[21]; g = nullptr; WT = (bf16*)(ws + WS_WP); K = PLE; N = D; }
        } else {
            if (r < I_UP) { W = a.in[17]; g = a.in[16]; WT = (bf16*)(ws + WS_WUP); K = D; N = FF; }
            else if ((r -= I_UP) < I_DN) { W = a.in[18]; g = nullptr; WT = (bf16*)(ws + WS_WDN); K = FF; N = D; }
            else { r -= I_DN; W = a.in[20]; g = a.in[19]; WT = (bf16*)(ws + WS_WG); K = D; N = D; }
        }
        const int nblk = N / 32, k0 = 64 * (r / nblk), n0 = 32 * (r % nblk);
        if (W == a.in[15]) g = (k0 < 512) ? a.in[13] + k0 : a.in[14] + (k0 - 512); else if (g) g += k0;
        p0_transpose_item(W, K, N, WT, g, scr, k0, n0, lane);
    }
}
__device__ __forceinline__ void p0_prologue(const Args& a, LAS unsigned char* lds, int G) {
    const int tid = opaque_tid(), lane = tid & 63, wave = __builtin_amdgcn_readfirstlane(tid >> 6);
    unsigned char* ws = a.ws;
    const int gw = opaque_bid() * NWAVES + wave, NGW = G * NWAVES;
    p0_weights(a, lds, 0, gw, NGW);
    float* rstd0 = (float*)(ws + WS_RSTD0); bf16* XB = (bf16*)(ws + WS_XB); bf16* PB = (bf16*)(ws + WS_PB);
    for (int m0 = 2 * gw; m0 < M; m0 += 2 * NGW) {
        f32x4 v[2][4]; f32x4 pv[2];
#pragma unroll
        for (int h = 0; h < 2; ++h) { const int m = m0 + h;
            const float* xrow = m < MP ? a.in[0] + (size_t)m * D : a.in[1] + (size_t)(m - MP) * D; const f32x4* xr = (const f32x4*)xrow + lane;
#pragma unroll
            for (int j = 0; j < 4; ++j) v[h][j] = __builtin_nontemporal_load(xr + 64 * j);
            const float* prow = m < MP ? a.in[2] + (size_t)m * PLE : a.in[3] + (size_t)(m - MP) * PLE; pv[h] = __builtin_nontemporal_load((const f32x4*)prow + lane); }
#pragma unroll
        for (int h = 0; h < 2; ++h) { const int m = m0 + h; float s = 0.f;
#pragma unroll
            for (int j = 0; j < 4; ++j) s += (v[h][j].x * v[h][j].x + v[h][j].y * v[h][j].y) + (v[h][j].z * v[h][j].z + v[h][j].w * v[h][j].w);
            s = wave_sum(s);
            if (lane == 0) rstd0[m] = rsqrtf(s * (1.0f / D) + EPS);
            v2u* o8 = (v2u*)(XB + (size_t)m * D) + lane;
#pragma unroll
            for (int j = 0; j < 4; ++j) { v2u o; o.x = pk2(v[h][j].x, v[h][j].y); o.y = pk2(v[h][j].z, v[h][j].w); o8[64 * j] = o; }
            v2u po; po.x = pk2(pv[h].x, pv[h].y); po.y = pk2(pv[h].z, pv[h].w); ((v2u*)(PB + (size_t)m * PLE))[lane] = po; }
    }
    float* rope = (float*)(ws + WS_ROPE);
    for (int idx = opaque_bid() * 512 + tid; idx < 2052 * 32; idx += G * 512) {
        const int pi = idx >> 5, i = idx & 31; const int pos = pi < 2048 ? pi : 16384 + (pi - 2048);
        const float inv_freq = exp2f(-(float)i * 0.41524101186092029f);
        const float ang = (float)pos * inv_freq;
        const double rev = (double)ang * 0.15915494309189535; const float fr = (float)(rev - floor(rev));
        rope[pi * 64 + i] = __builtin_amdgcn_cosf(fr); rope[pi * 64 + 32 + i] = __builtin_amdgcn_sinf(fr);
    }
}
constexpr int KST = 72, VST = 200, KROWS = 192;
constexpr int MX_KS = 0, MX_VT = 2 * KROWS * KST * 2, MX_RED = MX_VT + 2 * 64 * VST * 2;
static_assert(MX_RED + 64 * 8 * 4 <= 131072, "mixer LDS");

__device__ __forceinline__ void k_norm_rope(float (&x)[8], int j, const float* g, const float* rp) {
    float ss = 0.f;
#pragma unroll
    for (int e = 0; e < 8; ++e) ss += x[e] * x[e];
    ss += __shfl_xor(ss, 1); ss += __shfl_xor(ss, 2); ss += __shfl_xor(ss, 4);
    const float rstd = rsqrtf(ss * (1.0f / 64.0f) + EPS);
    const f32x4 g0 = *(const f32x4*)(g + 8 * j), g1 = *(const f32x4*)(g + 8 * j + 4);
    const int i0 = 8 * (j & 3);
    const f32x4 c0 = *(const f32x4*)(rp + i0), c1 = *(const f32x4*)(rp + i0 + 4), s0 = *(const f32x4*)(rp + 32 + i0), s1 = *(const f32x4*)(rp + 32 + i0 + 4);
    const float sg = (j < 4) ? -1.0f : 1.0f;
#pragma unroll
    for (int e = 0; e < 8; ++e) {
        const float y = x[e] * rstd * (e < 4 ? g0[e & 3] : g1[e & 3]);
        const float p = __shfl_xor(y, 4);
        const float c = e < 4 ? c0[e & 3] : c1[e & 3], s = e < 4 ? s0[e & 3] : s1[e & 3];
        x[e] = y * c + sg * p * s;
    }
}
__device__ __forceinline__ void q_frag_raw(const v4u w0, const v4u w1, const float* gq, const float* rp, int fq, s16x8& q0, s16x8& q1) {
    float x0[8], x1[8]; unpack8(w0, x0); unpack8(w1, x1);
    float ss = 0.f;
#pragma unroll
    for (int e = 0; e < 8; ++e) ss += x0[e] * x0[e] + x1[e] * x1[e];
    ss += __shfl_xor(ss, 16); ss += __shfl_xor(ss, 32);
    const float rstd = rsqrtf(ss * (1.0f / 64.0f) + EPS) * (LOG2E * 0.125f);
    const f32x4 ga = *(const f32x4*)(gq + 8 * fq), gb = *(const f32x4*)(gq + 8 * fq + 4), gc = *(const f32x4*)(gq + 32 + 8 * fq), gd = *(const f32x4*)(gq + 36 + 8 * fq);
    const f32x4 ca = *(const f32x4*)(rp + 8 * fq), cb = *(const f32x4*)(rp + 8 * fq + 4), sa = *(const f32x4*)(rp + 32 + 8 * fq), sb = *(const f32x4*)(rp + 36 + 8 * fq);
    float o0[8], o1[8];
#pragma unroll
    for (int e = 0; e < 8; ++e) {
        const float y0 = x0[e] * rstd * (e < 4 ? ga[e & 3] : gb[e & 3]), y1 = x1[e] * rstd * (e < 4 ? gc[e & 3] : gd[e & 3]);
        const float c = e < 4 ? ca[e & 3] : cb[e & 3], sn = e < 4 ? sa[e & 3] : sb[e & 3];
        o0[e] = y0 * c - y1 * sn; o1[e] = y1 * c + y0 * sn;
    }
    const v4u p0 = pack8(o0), p1 = pack8(o1);
    q0 = __builtin_bit_cast(s16x8, p0); q1 = __builtin_bit_cast(s16x8, p1);
}
__device__ __forceinline__ void q_frag(const bf16* zq  , const float* gq, const float* rp, int fq, s16x8& q0, s16x8& q1) {
    const v4u w0 = *(const v4u*)(zq + 8 * fq), w1 = *(const v4u*)(zq + 32 + 8 * fq);
    q_frag_raw(w0, w1, gq, rp, fq, q0, q1);
}
__device__ __forceinline__ void attn_strip(const LAS bf16* Ks, const LAS bf16* Vt, const s16x8 q0, const s16x8 q1, int tl, int jmin, float sink2, int fr, int fq, f32x4 (&O)[4]) {
    f32x4 S[9];
#pragma unroll
    for (int kt = 0; kt < 9; ++kt) {
        const LAS bf16* kp = Ks + (16 * kt + fr) * KST + 8 * fq;
        const s16x8 a0 = *(const LAS s16x8*)kp, a1 = *(const LAS s16x8*)(kp + 32);
        f32x4 c = {0.f, 0.f, 0.f, 0.f};
        c = __builtin_amdgcn_mfma_f32_16x16x32_bf16(a0, q0, c, 0, 0, 0);
        c = __builtin_amdgcn_mfma_f32_16x16x32_bf16(a1, q1, c, 0, 0, 0);
        S[kt] = c;
    }
    float mx = sink2;
#pragma unroll
    for (int i = 0; i < 4; ++i) { const int j0 = 4 * fq + i; if (!(j0 > tl)) S[0][i] = -1e30f; if (!(j0 <= tl)) S[8][i] = -1e30f; }
    if (jmin > 0) {
#pragma unroll
        for (int kt = 0; kt < 9; ++kt)
#pragma unroll
            for (int i = 0; i < 4; ++i) if (16 * kt + 4 * fq + i < jmin) S[kt][i] = -1e30f;
    }
#pragma unroll
    for (int kt = 0; kt < 9; ++kt)
#pragma unroll
        for (int i = 0; i < 4; ++i) mx = fmaxf(mx, S[kt][i]);
    mx = fmaxf(mx, __shfl_xor(mx, 16)); mx = fmaxf(mx, __shfl_xor(mx, 32));
    float sum = 0.f;
#pragma unroll
    for (int kt = 0; kt < 9; ++kt)
#pragma unroll
        for (int i = 0; i < 4; ++i) { const float e = __builtin_amdgcn_exp2f(S[kt][i] - mx); S[kt][i] = e; sum += e; }
    sum += __shfl_xor(sum, 16); sum += __shfl_xor(sum, 32);
    const float inv = 1.0f / (sum + __builtin_amdgcn_exp2f(sink2 - mx));
#pragma unroll
    for (int dt = 0; dt < 4; ++dt) O[dt] = (f32x4){0.f, 0.f, 0.f, 0.f};
#pragma unroll
    for (int p = 0; p < 4; ++p) {
        v4u pw; pw.x = pk2(S[2 * p][0] * inv, S[2 * p][1] * inv); pw.y = pk2(S[2 * p][2] * inv, S[2 * p][3] * inv); pw.z = pk2(S[2 * p + 1][0] * inv, S[2 * p + 1][1] * inv); pw.w = pk2(S[2 * p + 1][2] * inv, S[2 * p + 1][3] * inv);
        const s16x8 pb = __builtin_bit_cast(s16x8, pw);
#pragma unroll
        for (int dt = 0; dt < 4; ++dt) {
            const LAS bf16* vp = Vt + (16 * dt + fr) * VST + 32 * p + 4 * fq;
            const v2u lo = *(const LAS v2u*)vp, hi = *(const LAS v2u*)(vp + 16);
            const v4u va4 = (v4u){lo.x, lo.y, hi.x, hi.y};
            O[dt] = __builtin_amdgcn_mfma_f32_16x16x32_bf16(__builtin_bit_cast(s16x8, va4), pb, O[dt], 0, 0, 0);
        }
    }
    {
        v2u pw; pw.x = pk2(S[8][0] * inv, S[8][1] * inv); pw.y = pk2(S[8][2] * inv, S[8][3] * inv);
        const s16x4 pb = __builtin_bit_cast(s16x4, pw);
#pragma unroll
        for (int dt = 0; dt < 4; ++dt) {
            const s16x4 va = *(const LAS s16x4*)(Vt + (16 * dt + fr) * VST + 128 + 4 * fq);
            O[dt] = __builtin_amdgcn_mfma_f32_16x16x16bf16_1k(va, pb, O[dt], 0, 0, 0);
        }
    }
}
__device__ __forceinline__ void load_u(int mode, const bf16* z, size_t zrow, const float* st, int ch, float (&u)[8]) {
    if (mode == 1) { const v4u c = *(const v4u*)(z + zrow * NIN + 1280 + ch), h = *(const v4u*)(z + zrow * NIN + 1792 + ch); float a[8], b[8]; unpack8(c, a); unpack8(h, b);
#pragma unroll
        for (int e = 0; e < 8; ++e) u[e] = a[e] * b[e]; }
    else if (mode == 2) { const f32x4 a = *(const f32x4*)(st + ch), b = *(const f32x4*)(st + ch + 4); u[0] = a[0]; u[1] = a[1]; u[2] = a[2]; u[3] = a[3]; u[4] = b[0]; u[5] = b[1]; u[6] = b[2]; u[7] = b[3]; }
    else {
#pragma unroll
        for (int e = 0; e < 8; ++e) u[e] = 0.f; }
}
__device__ __forceinline__ void conv_token(const bf16* z, bf16* mixed, const float* convw, size_t row, int m1, size_t r1, const float* s1, int m2, size_t r2, const float* s2, float* u0out, int lane) {
    const int ch = 8 * lane; float u0[8], u1[8], u2[8];
    load_u(1, z, row, nullptr, ch, u0); load_u(m1, z, r1, s1, ch, u1); load_u(m2, z, r2, s2, ch, u2);
    const v4u bw = *(const v4u*)(z + row * NIN + 768 + ch); float bg[8]; unpack8(bw, bg);
    float w0[8], w1[8], w2[8];
#pragma unroll
    for (int h = 0; h < 2; ++h) { const f32x4 a = *(const f32x4*)(convw + ch + 4 * h), b = *(const f32x4*)(convw + 512 + ch + 4 * h), c = *(const f32x4*)(convw + 1024 + ch + 4 * h);
#pragma unroll
        for (int e = 0; e < 4; ++e) { w0[4 * h + e] = a[e]; w1[4 * h + e] = b[e]; w2[4 * h + e] = c[e]; } }
    float o[8]; float ss = 0.f;
#pragma unroll
    for (int e = 0; e < 8; ++e) { o[e] = bg[e] * (w0[e] * u2[e] + w1[e] * u1[e] + w2[e] * u0[e]); ss += o[e] * o[e]; }
    ss = wave_sum(ss);
    const float rstd = rsqrtf(ss * (1.0f / 512.0f) + EPS);
#pragma unroll
    for (int e = 0; e < 8; ++e) o[e] *= rstd;
    *(v4u*)(mixed + row * D + 512 + ch) = pack8(o);
    if (u0out) { *(f32x4*)(u0out + ch) = (f32x4){u0[0], u0[1], u0[2], u0[3]}; *(f32x4*)(u0out + ch + 4) = (f32x4){u0[4], u0[5], u0[6], u0[7]}; }
}

__device__ __forceinline__ void conv_tokens4(const bf16* z, bf16* mixed, const float* convw, size_t row0, int t, float* cp_out  , int lane) {
    const int ch = 8 * lane;
    v4u cw[6], hw[6], bw[4];
#pragma unroll
    for (int i = 0; i < 6; ++i) { const bool ok = (t + i - 2) >= 0; const size_t r = ok ? row0 + i - 2 : row0; cw[i] = *(const v4u*)(z + r * NIN + 1280 + ch); hw[i] = *(const v4u*)(z + r * NIN + 1792 + ch);
        if (!ok) { cw[i] = (v4u){0u, 0u, 0u, 0u}; } }
#pragma unroll
    for (int i = 0; i < 4; ++i) bw[i] = *(const v4u*)(z + (row0 + i) * NIN + 768 + ch);
    float w0[8], w1[8], w2[8];
#pragma unroll
    for (int h = 0; h < 2; ++h) { const f32x4 a = *(const f32x4*)(convw + ch + 4 * h), b = *(const f32x4*)(convw + 512 + ch + 4 * h), c = *(const f32x4*)(convw + 1024 + ch + 4 * h);
#pragma unroll
        for (int e = 0; e < 4; ++e) { w0[4 * h + e] = a[e]; w1[4 * h + e] = b[e]; w2[4 * h + e] = c[e]; } }
    float u[6][8];
#pragma unroll
    for (int i = 0; i < 6; ++i) { float a[8], b[8]; unpack8(cw[i], a); unpack8(hw[i], b);
#pragma unroll
        for (int e = 0; e < 8; ++e) u[i][e] = a[e] * b[e]; }
#pragma unroll
    for (int i = 0; i < 4; ++i) {
        float bg[8]; unpack8(bw[i], bg); float o[8]; float ss = 0.f;
#pragma unroll
        for (int e = 0; e < 8; ++e) { o[e] = bg[e] * (w0[e] * u[i][e] + w1[e] * u[i + 1][e] + w2[e] * u[i + 2][e]); ss += o[e] * o[e]; }
        ss = wave_sum(ss);
        const float rstd = rsqrtf(ss * (1.0f / 512.0f) + EPS);
#pragma unroll
        for (int e = 0; e < 8; ++e) o[e] *= rstd;
        *(v4u*)(mixed + (row0 + i) * D + 512 + ch) = pack8(o);
        if (cp_out && t + i >= SEQ - 2) { float* uo = cp_out + (size_t)(t + i - (SEQ - 2)) * 512 + ch;
            *(f32x4*)uo = (f32x4){u[i + 2][0], u[i + 2][1], u[i + 2][2], u[i + 2][3]}; *(f32x4*)(uo + 4) = (f32x4){u[i + 2][4], u[i + 2][5], u[i + 2][6], u[i + 2][7]}; }
    }
}

struct MixP { const bf16* z; bf16* mixed; const float* rope; const float *gq, *gk, *sinks, *convw, *cache_k, *cache_v, *state_conv; float* out; };

__device__ __forceinline__ void mixer_prompt_unit(const MixP& P, LAS unsigned char* lds, int b, int jblk, int conv_nb  ) {
    const int tid = opaque_tid(), lane = tid & 63, w = __builtin_amdgcn_readfirstlane(tid >> 6), fr = lane & 15, fq = lane >> 4;
    const int t0 = 64 * jblk; const bf16* z = P.z;
    v4u qraw[4][2];
#pragma unroll
    for (int s = 0; s < 4; ++s) { const bf16* zq = z + (size_t)(b * SEQ + t0 + 16 * s + fr) * NIN + w * 64; qraw[s][0] = *(const v4u*)(zq + 8 * fq); qraw[s][1] = *(const v4u*)(zq + 32 + 8 * fq); }
#pragma unroll
    for (int p = 0; p < 6; ++p) {
        const int id = p * 512 + tid, rowid = id >> 3, j = id & 7, kvh = rowid >= KROWS ? 1 : 0, r = rowid - KROWS * kvh;
        const int t = t0 - 128 + r; const bool valid = t >= 0; const int tc = valid ? t : 0;
        const v4u wv = *(const v4u*)(z + (size_t)(b * SEQ + tc) * NIN + 512 + kvh * 64 + 8 * j);
        float x[8]; unpack8(wv, x);
        k_norm_rope(x, j, P.gk, P.rope + tc * 64);
        if (!valid) {
#pragma unroll
            for (int e = 0; e < 8; ++e) x[e] = 0.f; }
        *(LAS v4u*)(lds + MX_KS + ((kvh * KROWS + r) * KST + 8 * j) * 2) = pack8(x);
        if (r >= 128 && t >= SEQ - 128) { float* kp = P.out + OFF_KP + ((size_t)((b * 128 + (t - (SEQ - 128))) * 2 + kvh)) * 64 + 8 * j;
            *(f32x4*)kp = (f32x4){x[0], x[1], x[2], x[3]}; *(f32x4*)(kp + 4) = (f32x4){x[4], x[5], x[6], x[7]}; }
    }
    for (int p = 0; p < 2; ++p) {
        const int id = p * 512 + tid;
        if (id < 768) {
            const int dc = id & 7, kg = (id >> 3) % 48, kvh = id / 384; float v[4][8];
#pragma unroll
            for (int kk = 0; kk < 4; ++kk) { const int r = 4 * kg + kk, t = t0 - 128 + r;
                if (t >= 0) { const v4u wv = *(const v4u*)(z + (size_t)(b * SEQ + t) * NIN + 640 + kvh * 64 + 8 * dc); unpack8(wv, v[kk]); }
                else {
#pragma unroll
                    for (int e = 0; e < 8; ++e) v[kk][e] = 0.f; }
                if (r >= 128 && t >= SEQ - 128) { float* vp = P.out + OFF_VP + ((size_t)((b * 128 + (t - (SEQ - 128))) * 2 + kvh)) * 64 + 8 * dc;
                    *(f32x4*)vp = (f32x4){v[kk][0], v[kk][1], v[kk][2], v[kk][3]}; *(f32x4*)(vp + 4) = (f32x4){v[kk][4], v[kk][5], v[kk][6], v[kk][7]}; } }
#pragma unroll
            for (int e = 0; e < 8; ++e) { v2u o; o.x = pk2(v[0][e], v[1][e]); o.y = pk2(v[2][e], v[3][e]); *(LAS v2u*)(lds + MX_VT + ((kvh * 64 + 8 * dc + e) * VST + 4 * kg) * 2) = o; }
        }
    }
    __syncthreads();
    f32x4 O[4][4]; LAS float* red = (LAS float*)(lds + MX_RED);
    const int kvh = w >> 2; const float sink2 = P.sinks[w] * LOG2E;
#pragma unroll
    for (int s = 0; s < 4; ++s) {
        const int tq = t0 + 16 * s + fr; s16x8 q0, q1;
        q_frag_raw(qraw[s][0], qraw[s][1], P.gq, P.rope + tq * 64, fq, q0, q1);
        attn_strip((const LAS bf16*)(lds + MX_KS) + (kvh * KROWS + 16 * s) * KST, (const LAS bf16*)(lds + MX_VT) + kvh * 64 * VST + 16 * s, q0, q1, fr, 128 - t0 - 16 * s, sink2, fr, fq, O[s]);
        float q = 0.f;
#pragma unroll
        for (int dt = 0; dt < 4; ++dt) q += (O[s][dt][0] * O[s][dt][0] + O[s][dt][1] * O[s][dt][1]) + (O[s][dt][2] * O[s][dt][2] + O[s][dt][3] * O[s][dt][3]);
        q += __shfl_xor(q, 16); q += __shfl_xor(q, 32);
        if (fq == 0) red[(16 * s + fr) * 8 + w] = q;
        __builtin_amdgcn_sched_barrier(0);
    }
    __syncthreads();
#pragma unroll
    for (int s = 0; s < 4; ++s) {
        const LAS f32x4* rr = (const LAS f32x4*)(red + (16 * s + fr) * 8); const f32x4 a = rr[0], c = rr[1];
        const float rstd = rsqrtf(((a[0] + a[1]) + (a[2] + a[3]) + (c[0] + c[1]) + (c[2] + c[3])) * (1.0f / 512.0f) + EPS);
        bf16* mp = P.mixed + (size_t)(b * SEQ + t0 + 16 * s + fr) * D + w * 64 + 4 * fq;
#pragma unroll
        for (int dt = 0; dt < 4; ++dt) { v2u o; o.x = pk2(O[s][dt][0] * rstd, O[s][dt][1] * rstd); o.y = pk2(O[s][dt][2] * rstd, O[s][dt][3] * rstd); *(v2u*)(mp + 16 * dt) = o; }
    }
    for (int i = 0; i < conv_nb; ++i) {
        const int t = t0 + 4 * (8 * i + w);
        conv_tokens4(z, P.mixed, P.convw, (size_t)b * SEQ + t, t, (t + 4 > SEQ - 2) ? P.out + OFF_CP + (size_t)b * 2 * 512 : nullptr, lane);
    }
    __syncthreads();
}

__device__ __forceinline__ void mixer_conv_half(const MixP& P, int b, int jblk) {
    const int lane = threadIdx.x & 63, w = __builtin_amdgcn_readfirstlane((int)(threadIdx.x >> 6));
    const int t = 64 * jblk + 4 * (8 + w);
    conv_tokens4(P.z, P.mixed, P.convw, (size_t)b * SEQ + t, t, (t + 4 > SEQ - 2) ? P.out + OFF_CP + (size_t)b * 2 * 512 : nullptr, lane);
}
__device__ __forceinline__ void mixer_sample_unit(const MixP& P, LAS unsigned char* lds, int sq) {
    const int tid = opaque_tid(), lane = tid & 63, w = __builtin_amdgcn_readfirstlane(tid >> 6), fr = lane & 15, fq = lane >> 4;
    const bf16* z = P.z; const size_t zr0 = (size_t)MP + 4 * sq;
    {
        f32x4 ca[4][2];
#pragma unroll
        for (int p = 0; p < 4; ++p) { const int id = p * 512 + tid, rowid = id >> 3, j = id & 7, kvh = rowid >> 7, r = rowid & 127;
            const float* cp = P.cache_k + ((size_t)(sq * 128 + r) * 2 + kvh) * 64 + 8 * j; ca[p][0] = *(const f32x4*)cp; ca[p][1] = *(const f32x4*)(cp + 4); }
#pragma unroll
        for (int p = 0; p < 4; ++p) { const int id = p * 512 + tid, rowid = id >> 3, j = id & 7, kvh = rowid >> 7, r = rowid & 127;
            v4u o; o.x = pk2(ca[p][0][0], ca[p][0][1]); o.y = pk2(ca[p][0][2], ca[p][0][3]); o.z = pk2(ca[p][1][0], ca[p][1][1]); o.w = pk2(ca[p][1][2], ca[p][1][3]);
            *(LAS v4u*)(lds + MX_KS + ((kvh * KROWS + r) * KST + 8 * j) * 2) = o;
            if (r >= 4) { float* kp = P.out + OFF_KS + ((size_t)(sq * 128 + (r - 4)) * 2 + kvh) * 64 + 8 * j; *(f32x4*)kp = ca[p][0]; *(f32x4*)(kp + 4) = ca[p][1]; } }
        if (w == 0) {
            const int rowid = lane >> 3, j = lane & 7, kvh = rowid >> 2, tn = rowid & 3;
            const v4u wv = *(const v4u*)(z + (zr0 + tn) * NIN + 512 + kvh * 64 + 8 * j);
            float x[8]; unpack8(wv, x);
            k_norm_rope(x, j, P.gk, P.rope + (2048 + tn) * 64);
            *(LAS v4u*)(lds + MX_KS + ((kvh * KROWS + 128 + tn) * KST + 8 * j) * 2) = pack8(x);
            float* kp = P.out + OFF_KS + ((size_t)(sq * 128 + 124 + tn) * 2 + kvh) * 64 + 8 * j;
            *(f32x4*)kp = (f32x4){x[0], x[1], x[2], x[3]}; *(f32x4*)(kp + 4) = (f32x4){x[4], x[5], x[6], x[7]};
        } else if (w == 1) {
#pragma unroll
            for (int p = 0; p < 3; ++p) { const int id = p * 64 + lane, rowid = id >> 3, j = id & 7, kvh = rowid / 12, r = 132 + rowid % 12;
                *(LAS v4u*)(lds + MX_KS + ((kvh * KROWS + r) * KST + 8 * j) * 2) = (v4u){0u, 0u, 0u, 0u}; }
        }
    }
    for (int p = 0; p < 2; ++p) {
        const int id = p * 512 + tid;
        if (id < 576) {
            const int dc = id & 7, kg = (id >> 3) % 36, kvh = id / 288; float v[4][8];
#pragma unroll
            for (int kk = 0; kk < 4; ++kk) { const int r = 4 * kg + kk;
                if (r < 128) { const float* cp = P.cache_v + ((size_t)(sq * 128 + r) * 2 + kvh) * 64 + 8 * dc; const f32x4 a = *(const f32x4*)cp, c = *(const f32x4*)(cp + 4);
                    v[kk][0] = a[0]; v[kk][1] = a[1]; v[kk][2] = a[2]; v[kk][3] = a[3]; v[kk][4] = c[0]; v[kk][5] = c[1]; v[kk][6] = c[2]; v[kk][7] = c[3]; }
                else if (r < 132) { const v4u wv = *(const v4u*)(z + (zr0 + (r - 128)) * NIN + 640 + kvh * 64 + 8 * dc); unpack8(wv, v[kk]); }
                else {
#pragma unroll
                    for (int e = 0; e < 8; ++e) v[kk][e] = 0.f; }
                if (r >= 4 && r < 132) { float* vp = P.out + OFF_VS + ((size_t)(sq * 128 + (r - 4)) * 2 + kvh) * 64 + 8 * dc;
                    *(f32x4*)vp = (f32x4){v[kk][0], v[kk][1], v[kk][2], v[kk][3]}; *(f32x4*)(vp + 4) = (f32x4){v[kk][4], v[kk][5], v[kk][6], v[kk][7]}; } }
#pragma unroll
            for (int e = 0; e < 8; ++e) { v2u o; o.x = pk2(v[0][e], v[1][e]); o.y = pk2(v[2][e], v[3][e]); *(LAS v2u*)(lds + MX_VT + ((kvh * 64 + 8 * dc + e) * VST + 4 * kg) * 2) = o; }
        }
    }
    __syncthreads();
    f32x4 O[4]; LAS float* red = (LAS float*)(lds + MX_RED);
    const int hh = fr >> 2, t = fr & 3, head = (w & 1) * 4 + hh;
    if (w < 2) {
        s16x8 q0, q1;
        q_frag(z + (zr0 + t) * NIN + head * 64, P.gq, P.rope + (2048 + t) * 64, fq, q0, q1);
        attn_strip((const LAS bf16*)(lds + MX_KS) + (w * KROWS) * KST, (const LAS bf16*)(lds + MX_VT) + w * 64 * VST, q0, q1, t, 0, P.sinks[head] * LOG2E, fr, fq, O);
        float q = 0.f;
#pragma unroll
        for (int dt = 0; dt < 4; ++dt) q += (O[dt][0] * O[dt][0] + O[dt][1] * O[dt][1]) + (O[dt][2] * O[dt][2] + O[dt][3] * O[dt][3]);
        q += __shfl_xor(q, 16); q += __shfl_xor(q, 32);
        if (fq == 0) red[t * 8 + head] = q;
    }
    __syncthreads();
    if (w < 2) {
        const LAS f32x4* rr = (const LAS f32x4*)(red + t * 8); const f32x4 a = rr[0], c = rr[1];
        const float rstd = rsqrtf(((a[0] + a[1]) + (a[2] + a[3]) + (c[0] + c[1]) + (c[2] + c[3])) * (1.0f / 512.0f) + EPS);
        bf16* mp = P.mixed + (zr0 + t) * D + head * 64 + 4 * fq;
#pragma unroll
        for (int dt = 0; dt < 4; ++dt) { v2u o; o.x = pk2(O[dt][0] * rstd, O[dt][1] * rstd); o.y = pk2(O[dt][2] * rstd, O[dt][3] * rstd); *(v2u*)(mp + 16 * dt) = o; }
    } else if (w < 6) {
        const int tt = w - 2; const size_t row = zr0 + tt; const float* st = P.state_conv + (size_t)sq * 2 * 512;
        float* uo = tt >= 2 ? P.out + OFF_CS + (size_t)(sq * 2 + (tt - 2)) * 512 : nullptr;
        conv_token(z, P.mixed, P.convw, row, tt >= 1 ? 1 : 2, row - 1, st + 512, tt >= 2 ? 1 : 2, row - 2, st + tt * 512, uo, lane);
    }
    __syncthreads();
}
template <int NA, int NBT, int KSB> struct MiniBatch { s16x8 a[KSB][NA], b[KSB][NBT]; };
template <int NA, int NBT, int KSB>
__device__ __forceinline__ void mb_load(MiniBatch<NA, NBT, KSB>& m, const bf16* ap, const bf16* bp, size_t lda16, size_t ldb16, int k0, int fq) {
#pragma unroll
    for (int s = 0; s < KSB; ++s) {
        const int ko = (KSB >= 2) ? k0 + 64 * (s >> 1) + 16 * fq + 8 * (s & 1) : k0 + 8 * fq;
#pragma unroll
        for (int mt = 0; mt < NA; ++mt) m.a[s][mt] = *(const s16x8*)(ap + mt * lda16 + ko);
#pragma unroll
        for (int nt = 0; nt < NBT; ++nt) m.b[s][nt] = *(const s16x8*)(bp + nt * ldb16 + ko);
    }
}
template <int NA, int NBT, int KSB>
__device__ __forceinline__ void mb_mma(f32x4 (&acc)[NA][NBT], const MiniBatch<NA, NBT, KSB>& m) {
#pragma unroll
    for (int s = 0; s < KSB; ++s)
#pragma unroll
        for (int mt = 0; mt < NA; ++mt)
#pragma unroll
            for (int nt = 0; nt < NBT; ++nt) acc[mt][nt] = __builtin_amdgcn_mfma_f32_16x16x32_bf16(m.b[s][nt], m.a[s][mt], acc[mt][nt], 0, 0, 0);
}
template <int NA, int NBT, int KSB, int NBATCH>
__device__ __forceinline__ void mb_run(f32x4 (&acc)[NA][NBT], const bf16* ap, const bf16* bp, size_t lda16, size_t ldb16, int fq) {
    MiniBatch<NA, NBT, KSB> buf[2];
#pragma unroll
    for (int i = 0; i < 2; ++i) if (i < NBATCH) mb_load(buf[i], ap, bp, lda16, ldb16, i * KSB * 32, fq);
    __builtin_amdgcn_sched_barrier(0);
#pragma unroll
    for (int i = 0; i < NBATCH; ++i) {
        mb_mma(acc, buf[i % 2]);
        __builtin_amdgcn_sched_barrier(0);
        if (i + 2 < NBATCH) { mb_load(buf[i % 2], ap, bp, lda16, ldb16, (i + 2) * KSB * 32, fq); __builtin_amdgcn_sched_barrier(0); }
    }
}
struct MiniEpi { bf16* O; int ldo; const float* rs; const float* ssp; const float* base; float* out; float* sspo; const bf16* pp; };
constexpr int MINI_RED2 = 65536;
template <int MODE, int K>
__device__ __forceinline__ void mini_tile(LAS unsigned char* lds, const bf16* A, const bf16* Bt, int r0, int c0, const MiniEpi& E) {
    const int tid = opaque_tid(), lane = tid & 63, w = __builtin_amdgcn_readfirstlane(tid >> 6), fr = lane & 15, fq = lane >> 4;
    constexpr int ks = K >> 3;
    const bf16* ap = A + (size_t)(r0 + fr) * K + w * ks;
    const bf16* bp = Bt + (size_t)(c0 + fr) * K + w * ks;
    f32x4 acc[2][4];
#pragma unroll
    for (int mt = 0; mt < 2; ++mt)
#pragma unroll
        for (int nt = 0; nt < 4; ++nt) acc[mt][nt] = (f32x4){0.f, 0.f, 0.f, 0.f};
    if constexpr (ks >= 64) mb_run<2, 4, 2, ks / 64>(acc, ap, bp, (size_t)16 * K, (size_t)16 * K, fq);
    else mb_run<2, 4, 1, 1>(acc, ap, bp, (size_t)16 * K, (size_t)16 * K, fq);
    LAS f32x4* red = (LAS f32x4*)lds;
#pragma unroll
    for (int mt = 0; mt < 2; ++mt)
#pragma unroll
        for (int nt = 0; nt < 4; ++nt) red[w * 512 + (mt * 4 + nt) * 64 + lane] = acc[mt][nt];
    __syncthreads();
    f32x4 v = red[tid];
#pragma unroll
    for (int ww = 1; ww < 8; ++ww) v += red[ww * 512 + tid];
    const int mt = tid >> 8, nt = (tid >> 6) & 3, rl = 16 * mt + fr, row = r0 + rl, col = c0 + 16 * nt + 4 * fq; const size_t R = (size_t)MP + row;
    if constexpr (MODE == 0) {
        const float sc = E.rs ? E.rs[R] : 1.0f; v2u o; o.x = pk2(v[0] * sc, v[1] * sc); o.y = pk2(v[2] * sc, v[3] * sc); *(v2u*)(E.O + R * E.ldo + col) = o;
    } else if constexpr (MODE == 1) {
        const float sc = pg8::rstd_from_ssp(E.ssp, (int)R); float t[4];
#pragma unroll
        for (int e = 0; e < 4; ++e) { const float x = fmaxf(v[e] * sc, 0.f); t[e] = x * x; }
        v2u o; o.x = pk2(t[0], t[1]); o.y = pk2(t[2], t[3]); *(v2u*)(E.O + R * E.ldo + col) = o;
    } else if constexpr (MODE == 2 || MODE == 4) {
        if constexpr (MODE == 2) { const f32x4 b = *(const f32x4*)(E.base + (size_t)row * 1024 + col); v += b; }
        else { const v2u bw = *(const v2u*)(E.pp + R * 1024 + col); v += (f32x4){bflo(bw.x), bfhi(bw.x), bflo(bw.y), bfhi(bw.y)}; }
        v2u o; o.x = pk2(v[0], v[1]); o.y = pk2(v[2], v[3]); *(v2u*)(E.O + R * 1024 + col) = o;
        LAS float* red2 = (LAS float*)(lds + MINI_RED2);
        red2[rl * 16 + nt * 4 + fq] = (v[0] * v[0] + v[1] * v[1]) + (v[2] * v[2] + v[3] * v[3]);
        __syncthreads();
        if (tid < 32) { const LAS f32x4* p = (const LAS f32x4*)(red2 + tid * 16); const f32x4 s = (p[0] + p[1]) + (p[2] + p[3]); E.sspo[((size_t)MP + r0 + tid) * 16 + (c0 >> 6)] = (s[0] + s[1]) + (s[2] + s[3]); }
    } else {
        const float sc = pg8::rstd_from_ssp(E.ssp, (int)R); const v2u xw = *(const v2u*)(E.O + R * 1024 + col); const v2u pw = *(const v2u*)(E.pp + R * 1024 + col);
        const float xv[4] = {bflo(xw.x), bfhi(xw.x), bflo(xw.y), bfhi(xw.y)}; const float pv[4] = {bflo(pw.x), bfhi(pw.x), bflo(pw.y), bfhi(pw.y)}; f32x4 y;
#pragma unroll
        for (int e = 0; e < 4; ++e) y[e] = xv[e] + pv[e] / (1.0f + __expf(-v[e] * sc));
        *(f32x4*)(E.out + R * 1024 + col) = y;
    }
    __syncthreads();
}
template <int MODE, int K>
__device__ __forceinline__ void mini_gemm(LAS unsigned char* lds, const bf16* A, const bf16* Bt, int N, const MiniEpi& E, int G) {
    const int ncb = N >> 6, nt = 16 * ncb;
    for (int t = blockIdx.x; t < nt; t += G) mini_tile<MODE, K>(lds, A, Bt, 32 * (t / ncb), 64 * (t % ncb), E);
}

__device__ __forceinline__ void mini_up(LAS unsigned char* lds, const bf16* A, const bf16* Bt, const float* ssp, bf16* U, int G) {
    const int tid_ = opaque_tid(); const int lane = tid_ & 63, w = __builtin_amdgcn_readfirstlane(tid_ >> 6), fr = lane & 15, fq = lane >> 4;
    for (int t = blockIdx.x; t < 256; t += G) {
        const int r0 = 32 * (t >> 4), c0 = 256 * (t & 15) + 32 * w;
        {
            s16x8 av[8];
#pragma unroll
            for (int i = 0; i < 8; ++i) { const int pc = 8 * w + i, mt = pc >> 5, ksx = pc & 31; av[i] = *(const s16x8*)(A + (size_t)(r0 + 16 * mt + fr) * D + 64 * (ksx >> 1) + 16 * fq + 8 * (ksx & 1)); }
#pragma unroll
            for (int i = 0; i < 8; ++i) *(LAS s16x8*)(lds + (8 * w + i) * 1024 + lane * 16) = av[i];
        }
        __syncthreads();
        const bf16* bp = Bt + (size_t)(c0 + fr) * D;
        f32x4 acc[2][2];
#pragma unroll
        for (int mt = 0; mt < 2; ++mt)
#pragma unroll
            for (int nt = 0; nt < 2; ++nt) acc[mt][nt] = (f32x4){0.f, 0.f, 0.f, 0.f};
        s16x8 bb[2][4][2];
#define MU_LOAD(buf, b) do { _Pragma("unroll") for (int s_ = 0; s_ < 4; ++s_) { const int ko = 128 * (b) + 64 * (s_ >> 1) + 16 * fq + 8 * (s_ & 1); \
            _Pragma("unroll") for (int nt = 0; nt < 2; ++nt) bb[buf][s_][nt] = *(const s16x8*)(bp + (size_t)nt * 16 * D + ko); } } while (0)
#define MU_MMA(buf, b) do { _Pragma("unroll") for (int s_ = 0; s_ < 4; ++s_) { const int ksx = 4 * (b) + s_; \
            const s16x8 a0 = *(const LAS s16x8*)(lds + ksx * 1024 + lane * 16), a1 = *(const LAS s16x8*)(lds + (32 + ksx) * 1024 + lane * 16); \
            _Pragma("unroll") for (int nt = 0; nt < 2; ++nt) { acc[0][nt] = __builtin_amdgcn_mfma_f32_16x16x32_bf16(bb[buf][s_][nt], a0, acc[0][nt], 0, 0, 0); acc[1][nt] = __builtin_amdgcn_mfma_f32_16x16x32_bf16(bb[buf][s_][nt], a1, acc[1][nt], 0, 0, 0); } } } while (0)
        MU_LOAD(0, 0); MU_LOAD(1, 1);
        MU_MMA(0, 0); MU_LOAD(0, 2); MU_MMA(1, 1); MU_LOAD(1, 3); MU_MMA(0, 2); MU_LOAD(0, 4); MU_MMA(1, 3); MU_LOAD(1, 5);
        MU_MMA(0, 4); MU_LOAD(0, 6); MU_MMA(1, 5); MU_LOAD(1, 7); MU_MMA(0, 6); MU_MMA(1, 7);
#undef MU_LOAD
#undef MU_MMA
#pragma unroll
        for (int mt = 0; mt < 2; ++mt) { const size_t R = (size_t)MP + r0 + 16 * mt + fr; const float sc = pg8::rstd_from_ssp(ssp, (int)R);
#pragma unroll
            for (int nt = 0; nt < 2; ++nt) { float tv[4];
#pragma unroll
                for (int e = 0; e < 4; ++e) { const float x = fmaxf(acc[mt][nt][e] * sc, 0.f); tv[e] = x * x; }
                v2u o; o.x = pk2(tv[0], tv[1]); o.y = pk2(tv[2], tv[3]); *(v2u*)(U + R * FF + c0 + 16 * nt + 4 * fq) = o; } }
        __syncthreads();
    }
}

constexpr int WS_SCNT_WORD = 3584;
struct P1Order {
    pg8::StaticOrder S; int c; unsigned* cnt;
    __device__ bool next(int i, pg8::Unit& u) const {
        if (c >= 64 && c < 82) { if (i == 0) { u.pm = 64 + (c - 64) / 9; u.pn = (c - 64) % 9; return true; } return S.next(i - 1, u); }
        return S.next(i, u);
    }
    __device__ __forceinline__ void a_ready(const pg8::Unit&) const {}
    __device__ __forceinline__ void done(const pg8::Unit& u) const {
        if (u.pm >= 64) {
            asm volatile("s_waitcnt vmcnt(0)" ::: "memory");
            __builtin_amdgcn_fence(__ATOMIC_RELEASE, "agent");
            asm volatile("s_waitcnt vmcnt(0)" ::: "memory");
            if ((threadIdx.x & 63) == 0) __hip_atomic_fetch_add(cnt, 1u, __ATOMIC_RELAXED, __HIP_MEMORY_SCOPE_AGENT);
        }
    }
};

#define XB_TMO      128
#define XB_XCNT(j)  (256  + 64 * (j))
#define XB_XSUB(j)  (1280 + 64 * (j))
#define XB_XGEN(j)  (2304 + 64 * (j))
#define XB_TOP      3328
#define XB_TOPGEN   3392
#define XCD_BAR_WORDS 3456
#define XB_SPIN_CAP (1u << 18)

__device__ __forceinline__ unsigned xb_ld(unsigned* p)              { return __hip_atomic_load(p, __ATOMIC_RELAXED, __HIP_MEMORY_SCOPE_AGENT); }
__device__ __forceinline__ unsigned xb_add(unsigned* p, unsigned v) { return __hip_atomic_fetch_add(p, v, __ATOMIC_RELAXED, __HIP_MEMORY_SCOPE_AGENT); }
__device__ __forceinline__ unsigned xb_xcc_id() { return (unsigned)__builtin_amdgcn_s_getreg((3 << 11) | 20) & 0xFu; }
#define XB_SPIN(cond, bar) do { unsigned _sp = 0; while (cond) { __builtin_amdgcn_s_sleep(1); \
    if ((++_sp & 255u) == 0u) { if (xb_ld(&(bar)[XB_TMO])) break; if (_sp > XB_SPIN_CAP) { atomicAdd(&(bar)[XB_TMO], 1u); break; } } } } while (0)

struct XcdBarrier {
    unsigned* bar; unsigned x;
    volatile LAS unsigned* st;
};

__device__ __forceinline__ XcdBarrier xcd_barrier_post(unsigned* bar, volatile LAS unsigned* st) {
    XcdBarrier b; b.bar = bar; b.x = xb_xcc_id(); b.st = st;
    if (threadIdx.x == 0) (void)xb_add(&bar[XB_XCNT(b.x)], 1u);
    return b;
}
__device__ __forceinline__ void xcd_barrier_complete(unsigned* bar, unsigned x, unsigned& nloc, unsigned& nx) {
    const unsigned G = gridDim.x * gridDim.y * gridDim.z;
    unsigned sum, cnt, mine, sp = 0u;
    for (;;) {
        sum = 0u; cnt = 0u; mine = 0u;
#pragma unroll
        for (unsigned j = 0; j < 16; ++j) { const unsigned c = xb_ld(&bar[XB_XCNT(j)]); sum += c; cnt += (c > 0u) ? 1u : 0u; mine = (j == x) ? c : mine; }
        if (sum == G) break;
        __builtin_amdgcn_s_sleep(1);
        if ((++sp & 255u) == 0u) { if (xb_ld(&bar[XB_TMO])) break; if (sp > XB_SPIN_CAP) { atomicAdd(&bar[XB_TMO], 1u); break; } }
    }
    nloc = mine > 0u ? mine : 1u; nx = cnt > 0u ? cnt : 1u;
}

__device__ __forceinline__ void xcd_barrier(const XcdBarrier& b) {
    asm volatile("s_waitcnt vmcnt(0)" ::: "memory");
    __syncthreads();
    if (threadIdx.x == 0) {
        unsigned* bar = b.bar;
        __builtin_amdgcn_s_waitcnt(0);
        unsigned nloc = b.st[0], nx = b.st[1];
        if (nloc == 0u) { xcd_barrier_complete(bar, b.x, nloc, nx); b.st[0] = nloc; b.st[1] = nx; }
        const unsigned old = xb_add(&bar[XB_XSUB(b.x)], 1u);
        const unsigned gen = old / nloc;
        if (old + 1u == (gen + 1u) * nloc) {
            __builtin_amdgcn_fence(__ATOMIC_RELEASE, "agent");
            asm volatile("s_waitcnt vmcnt(0)" ::: "memory");
            const unsigned og = xb_add(&bar[XB_TOP], 1u);
            const unsigned tg = og / nx;
            if (og + 1u == (tg + 1u) * nx) xb_add(&bar[XB_TOPGEN], 1u);
            else XB_SPIN(xb_ld(&bar[XB_TOPGEN]) == tg, bar);
            __builtin_amdgcn_fence(__ATOMIC_ACQUIRE, "agent");
            xb_add(&bar[XB_XGEN(b.x)], 1u);
            asm volatile("s_waitcnt vmcnt(0)" ::: "memory");
        } else {
            XB_SPIN(xb_ld(&bar[XB_XGEN(b.x)]) == gen, bar);
            __builtin_amdgcn_fence(__ATOMIC_ACQUIRE, "agent");
            asm volatile("s_waitcnt vmcnt(0)" ::: "memory");
        }
    }
    __syncthreads();
}

#ifndef COOP
#define COOP 1
#endif
constexpr int N_PHASES = 7;
#ifndef DUP_PHASE
#define DUP_PHASE -1
#endif
#ifndef EXTRA_SYNCS
#define EXTRA_SYNCS 0
#endif
#define REPS(k) for (int rep_ = 0; rep_ < ((DUP_PHASE == (k)) ? 2 : 1); ++rep_)
#define DUPSYNC(k) do { if (DUP_PHASE == (k) && rep_ == 0) xcd_barrier(bar); } while (0)

__global__ void __launch_bounds__(NWAVES * 64, 2) fwd_megakernel(Args a) {
    extern __shared__ __attribute__((aligned(16))) unsigned char lds_raw[];
    LAS unsigned char* lds = (LAS unsigned char*)lds_raw;
    const int G = gridDim.x, lo = a.ph_lo, hi = a.ph_hi;
    unsigned char* ws = a.ws;
    volatile LAS unsigned* MISC = (volatile LAS unsigned*)(lds + 131072);
    if (threadIdx.x < 64) MISC[threadIdx.x] = 0u;
    __syncthreads();
    XcdBarrier bar = xcd_barrier_post((unsigned*)(ws + WS_BAR), MISC + 8);
    bf16 *WIN = (bf16*)(ws + WS_WIN), *WO = (bf16*)(ws + WS_WO), *WUP = (bf16*)(ws + WS_WUP), *WDN = (bf16*)(ws + WS_WDN), *WG = (bf16*)(ws + WS_WG), *WP = (bf16*)(ws + WS_WP);
    bf16 *XB = (bf16*)(ws + WS_XB), *PB = (bf16*)(ws + WS_PB), *Z = (bf16*)(ws + WS_Z), *MIXED = (bf16*)(ws + WS_MIXED), *X1B = (bf16*)(ws + WS_X1B), *U = (bf16*)(ws + WS_U), *X2B = (bf16*)(ws + WS_X2B), *PPB = (bf16*)(ws + WS_PPB);
    float *RSTD0 = (float*)(ws + WS_RSTD0), *ROPE = (float*)(ws + WS_ROPE), *SS1 = (float*)(ws + WS_SS1), *SS2 = (float*)(ws + WS_SS2);
#ifndef PH_MASK
#define PH_MASK 0x7f
#endif
#define IN(k) (((PH_MASK >> (k)) & 1) && lo <= (k) && (k) < hi)
#if COOP
#define SEAM(k) do { if (IN(k) && IN((k) + 1)) xcd_barrier(bar); } while (0)
#else
#define SEAM(k) do { } while (0)
#endif
    typedef pg8::StaticOrder SO;
    if (hi > 1000) cg::this_grid().sync();
    for (int i_ = 0; i_ < EXTRA_SYNCS; ++i_) xcd_barrier(bar);
    if (IN(0)) REPS(0) { p0_prologue(a, lds, G); __syncthreads(); DUPSYNC(0); }
    SEAM(0);
    if (IN(1)) REPS(1) {
        unsigned* scnt = (unsigned*)(ws + WS_BAR) + WS_SCNT_WORD;
        pg8::Gemm g{XB, WIN, M, NIN, D}; P1Order S; S.S.init(MP, NIN, G, (int)blockIdx.x); S.c = (G == 256) ? (int)blockIdx.x : -1; S.cnt = scnt;
        pg8::Epi<0> E{Z, NIN, RSTD0, nullptr, nullptr, nullptr, nullptr, nullptr, nullptr};
        if (G == 256) pg8::gemm_phase<pg8::Epi<0>, P1Order, true, true>(lds, g, S, E);
        if ((int)blockIdx.x >= P1_LIGHT0) {
            const int c = (int)blockIdx.x, wv = __builtin_amdgcn_readfirstlane((int)(threadIdx.x >> 6));
            if (c < P1_LIGHT0 + 128) p0_weights(a, lds, 1, (c - P1_LIGHT0) * NWAVES + wv, 128 * NWAVES, 2048);
            else p0_weights(a, lds, 1, 2048 + (c - P1_LIGHT0 - 128) * NWAVES + wv, (G - P1_LIGHT0 - 128) * NWAVES);
        }
        if (G == 256 && (int)blockIdx.x >= P1_LIGHT0) {
            if (threadIdx.x == 0) { unsigned sp = 0; while (__hip_atomic_load(scnt, __ATOMIC_RELAXED, __HIP_MEMORY_SCOPE_AGENT) < 144u) { __builtin_amdgcn_s_sleep(8); if (++sp > (1u << 22)) break; }
                __builtin_amdgcn_fence(__ATOMIC_ACQUIRE, "agent"); asm volatile("s_waitcnt vmcnt(0)" ::: "memory"); }
            __syncthreads();
            MixP P{Z, MIXED, ROPE, a.in[9], a.in[10], a.in[11], a.in[12], a.in[4], a.in[5], a.in[6], a.out};
            for (int u = (int)blockIdx.x - P1_LIGHT0; u < 128; u += G - P1_LIGHT0) mixer_sample_unit(P, lds, u);
        }
        DUPSYNC(1);
    }
    SEAM(1);
    if (IN(2)) REPS(2) {
        MixP P{Z, MIXED, ROPE, a.in[9], a.in[10], a.in[11], a.in[12], a.in[4], a.in[5], a.in[6], a.out};
        for (int u = blockIdx.x; u < 256; u += G) mixer_prompt_unit(P, lds, u & 7, u >> 3, 2);
        DUPSYNC(2);
    }
    SEAM(2);
    if (IN(3)) REPS(3) {
        pg8::Gemm g{MIXED, WO, MP, D, D}; SO S; S.init(MP, D, G, (int)blockIdx.x);
        pg8::Epi<4> E{X1B, D, nullptr, nullptr, nullptr, nullptr, nullptr, SS1, XB};
        pg8::gemm_phase<pg8::Epi<4>, SO, true, true>(lds, g, S, E);
        MiniEpi ME{X1B, D, nullptr, nullptr, nullptr, nullptr, SS1, XB};
        mini_gemm<4, D>(lds, MIXED + (size_t)MP * D, WO, D, ME, G); DUPSYNC(3);
    }
    SEAM(3);
    if (IN(4)) REPS(4) {
        pg8::Gemm g{X1B, WUP, MP, FF, D}; SO S; S.init(MP, FF, G, (int)blockIdx.x);
        pg8::Epi<1> E{U, FF, nullptr, SS1, nullptr, nullptr, nullptr, nullptr, nullptr};
        pg8::gemm_phase<pg8::Epi<1>, SO, true, true>(lds, g, S, E);
        mini_up(lds, X1B + (size_t)MP * D, WUP, SS1, U, G); DUPSYNC(4);
    }
    SEAM(4);
    if (IN(5)) REPS(5) {
        pg8::Gemm g{U, WDN, MP, D, FF}; SO S; S.init(MP, D, G, (int)blockIdx.x);
        pg8::Epi<4> E{X2B, D, nullptr, nullptr, nullptr, nullptr, nullptr, SS2, X1B};
        pg8::gemm_phase<pg8::Epi<4>, SO, true, true>(lds, g, S, E);
        { MiniEpi ME{X2B, D, nullptr, nullptr, nullptr, nullptr, SS2, X1B};
            mini_gemm<4, FF>(lds, U + (size_t)MP * FF, WDN, D, ME, G); }
        DUPSYNC(5);
    }
    SEAM(5);
    if (IN(6) && DUP_PHASE == 6) { pg8::Gemm g{X2B, WG, MP, D, D}; SO S; S.init(MP, D, G, (int)blockIdx.x);
          pg8::Epi<0> E{X1B, D, nullptr, nullptr, nullptr, nullptr, nullptr, nullptr, nullptr};
          pg8::gemm_phase<pg8::Epi<0>, SO, true, true>(lds, g, S, E); xcd_barrier(bar); }
    if (IN(6)) {
        { pg8::Gemm g{PB, WP, MP, D, PLE}; SO S; S.init(MP, D, G, (int)blockIdx.x);
          pg8::Epi<0> E{PPB, D, nullptr, nullptr, nullptr, nullptr, nullptr, nullptr, nullptr};
          pg8::gemm_phase<pg8::Epi<0>, SO, true, true>(lds, g, S, E); }
        { pg8::Gemm g{X2B, WG, MP, D, D}; SO S; S.init(MP, D, G, (int)blockIdx.x);
          pg8::Epi<3> E{X2B, D, nullptr, SS2, nullptr, nullptr, a.out, nullptr, PPB};
          pg8::gemm_phase<pg8::Epi<3>, SO, true, true>(lds, g, S, E); }
        { MiniEpi ME0{PPB, D, nullptr, nullptr, nullptr, nullptr, nullptr, nullptr}; mini_gemm<0, PLE>(lds, PB + (size_t)MP * PLE, WP, D, ME0, G);
          MiniEpi ME3{X2B, D, nullptr, SS2, nullptr, a.out, nullptr, PPB}; mini_gemm<3, D>(lds, X2B + (size_t)MP * D, WG, D, ME3, G); }
    }
#undef IN
#undef SEAM
}

extern "C" void kernel_launch(void* const* d_in, const int* in_sizes, int n_in, void* d_out, int out_size, void* d_ws, size_t ws_size, hipStream_t stream) {
    static int grid = 0;
    if (grid == 0) {
        if (n_in != 22 || in_sizes[0] != MP * D || out_size != (int)OUT_TOTAL || ws_size < WS_END) {
            fprintf(stderr, "kernel_launch: unexpected shapes: n_in %d in0 %d out %d ws %zu (need out %zu ws %zu)\n", n_in, n_in > 0 ? in_sizes[0] : -1, out_size, ws_size, (size_t)OUT_TOTAL, (size_t)WS_END); grid = -1; return; }
        int dev = 0, cus = 0, per_cu = 0;
        hipGetDevice(&dev); hipDeviceGetAttribute(&cus, hipDeviceAttributeMultiprocessorCount, dev);
        if (hipFuncSetAttribute((const void*)fwd_megakernel, hipFuncAttributeMaxDynamicSharedMemorySize, LDS_BYTES) != hipSuccess) { fprintf(stderr, "kernel_launch: hipFuncSetAttribute failed\n"); grid = -1; return; }
        if (hipOccupancyMaxActiveBlocksPerMultiprocessor(&per_cu, (const void*)fwd_megakernel, NWAVES * 64, LDS_BYTES) != hipSuccess || per_cu < 1) { fprintf(stderr, "kernel_launch: occupancy query says %d\n", per_cu); per_cu = 1; }
        (void)hipGetLastError();
        grid = cus;
        if (grid != 256) { fprintf(stderr, "kernel_launch: this build's phase program is laid out for 256 CUs (got %d); nothing launched\n", cus); grid = -1; return; }
        fprintf(stderr, "kernel_launch: cus %d per_cu %d grid %d\n", cus, per_cu, grid);
    }
    if (grid < 0) return;
    Args a{};
    for (int i = 0; i < 22; ++i) a.in[i] = (const float*)d_in[i];
    a.out = (float*)d_out; a.ws = (unsigned char*)d_ws;
#if COOP
    if (hipMemsetAsync((char*)d_ws + WS_BAR, 0, WS_BAR_BYTES, stream) != hipSuccess) { fprintf(stderr, "kernel_launch: memset failed\n"); return; }
    a.ph_lo = 0; a.ph_hi = N_PHASES;
    void* args[] = {&a};
    hipError_t e = hipLaunchCooperativeKernel((const void*)fwd_megakernel, dim3(grid), dim3(NWAVES * 64), args, LDS_BYTES, stream);
    if (e != hipSuccess) fprintf(stderr, "kernel_launch: cooperative launch failed: %s (grid %d)\n", hipGetErrorString(e), grid);
#else
    for (int p = 0; p < N_PHASES; ++p) { a.ph_lo = p; a.ph_hi = p + 1; hipLaunchKernelGGL(fwd_megakernel, dim3(grid), dim3(NWAVES * 64), LDS_BYTES, stream, a); }
#endif
}
```

```cpp
#include <hip/hip_runtime.h>
#include <hip/hip_cooperative_groups.h>
#include <cstdio>
#include <cstdint>
namespace cg = cooperative_groups;
__device__ __forceinline__ int opaque_tid() { int t = (int)threadIdx.x; asm volatile("" : "+v"(t)); return t; }
__device__ __forceinline__ int opaque_bid() { return (int)blockIdx.x; }
namespace pg8 {
#define PG8_LAS __attribute__((address_space(3)))
typedef unsigned short bf16_t;
typedef short bf16x8 __attribute__((ext_vector_type(8)));
typedef float f32x4 __attribute__((ext_vector_type(4)));
typedef unsigned u32x4 __attribute__((ext_vector_type(4)));
constexpr int BM = 256, BK = 64, HALF = 128, HTB = HALF * BK * 2  , STAGE_BYTES = 8 * HTB, NXCD = 8, WGM = 8;

__host__ __device__ __forceinline__ int lds_byte(int r, int c) { const int st = (r >> 4) * 2 + (c >> 5), rr = r & 15, cc = c & 31, ob = rr * 64 + cc * 2; return st * 1024 + (ob ^ (((ob >> 9) & 1) << 5)); }
__host__ __device__ __forceinline__ void stage_rc(int b, int& R, int& C) { const int st = b / 1024, sb = b % 1024, swz = sb ^ (((sb >> 9) & 1) << 5); R = (st >> 1) * 16 + swz / 64; C = (st & 1) * 32 + (swz % 64) / 2; }
__host__ __device__ __forceinline__ int perm32(int rho) { const int n = rho >> 4, i = rho & 15; return 8 * (i >> 2) + 4 * n + (i & 3); }

struct Unit { int pm, pn; };
struct Gemm { const bf16_t* A; const bf16_t* Bt; int M, N, K; };

struct StaticOrder {
    int nM, nN, nwg, G, c;
    __host__ __device__ void init(int M, int N, int G_, int c_) { nM = M / BM; nN = N / BM; nwg = nM * nN; G = G_; c = c_; }
    __host__ __device__ bool next(int i, Unit& u) const {
        const long L = (long)i * G + c; if (L >= nwg) return false;
        int wgid = (int)L; { const int q = nwg / NXCD, r = nwg % NXCD, xcd = wgid % NXCD, off = wgid / NXCD; wgid = (xcd < r ? xcd * (q + 1) : r * (q + 1) + (xcd - r) * q) + off; }
        const int nig = WGM * nN, gid = wgid / nig, fm = gid * WGM, gsz = (nM - fm) < WGM ? (nM - fm) : WGM;
        u.pm = fm + ((wgid % nig) % gsz); u.pn = (wgid % nig) / gsz; return true;
    }
    __device__ __forceinline__ void a_ready(const Unit&) const {}
    __device__ __forceinline__ void done(const Unit&) const {}
};

__device__ __forceinline__ unsigned cvt_pk_bf16(float lo, float hi) { unsigned r; asm volatile("v_cvt_pk_bf16_f32 %0, %1, %2" : "=v"(r) : "v"(lo), "v"(hi)); return r; }
typedef float f32x2 __attribute__((ext_vector_type(2)));
constexpr float RMS_EPS = 1e-6f;
__device__ __forceinline__ float rstd_from_ssp(const float* ssp, int row) {
    const f32x4* p = (const f32x4*)(ssp + (size_t)row * 16); const f32x4 s = (p[0] + p[1]) + (p[2] + p[3]);
    return rsqrtf(((s[0] + s[1]) + (s[2] + s[3])) * (1.0f / 1024.0f) + RMS_EPS);
}
__device__ __forceinline__ void unpack_bf16x8(const u32x4 w, f32x4& lo, f32x4& hi) {
    lo = (f32x4){__uint_as_float(w.x << 16), __uint_as_float(w.x & 0xffff0000u), __uint_as_float(w.y << 16), __uint_as_float(w.y & 0xffff0000u)};
    hi = (f32x4){__uint_as_float(w.z << 16), __uint_as_float(w.z & 0xffff0000u), __uint_as_float(w.w << 16), __uint_as_float(w.w & 0xffff0000u)};
}
template <int MODE> struct Epi {
    static constexpr bool PERM = true, AFTER_DRAIN = false;
    bf16_t* O; int ldo; const float* rs; const float* ssp;
    const float* base0; const float* base1; float* out; float* sspo; const bf16_t* pp;
    __device__ __forceinline__ void operator()(const f32x4 (&acc)[2][2][4][2], const Unit& u, int wr, int wc, int fr, int fq) const {
        const int row0 = u.pm * BM + wr * 64 + fr, col0 = u.pn * BM + wc * 32 + 8 * fq;
        float sc[2][4];
        if constexpr (MODE == 0) {
#pragma unroll
            for (int ai = 0; ai < 2; ++ai)
#pragma unroll
                for (int m = 0; m < 4; ++m) sc[ai][m] = rs ? rs[row0 + ai * HALF + m * 16] : 1.0f;
        } else if constexpr (MODE == 1 || MODE == 3) {
            f32x4 pz[2][4];
#pragma unroll
            for (int ai = 0; ai < 2; ++ai)
#pragma unroll
                for (int m = 0; m < 4; ++m) pz[ai][m] = *(const f32x4*)(ssp + (size_t)(row0 + ai * HALF + m * 16) * 16 + 4 * fq);
#pragma unroll
            for (int ai = 0; ai < 2; ++ai)
#pragma unroll
                for (int m = 0; m < 4; ++m) { float t = (pz[ai][m][0] + pz[ai][m][1]) + (pz[ai][m][2] + pz[ai][m][3]); t += __shfl_xor(t, 16); t += __shfl_xor(t, 32);
                    sc[ai][m] = rsqrtf(t * (1.0f / 1024.0f) + RMS_EPS); }
        }
        if constexpr (MODE == 0 || MODE == 1) {
#pragma unroll
            for (int ai = 0; ai < 2; ++ai)
#pragma unroll
                for (int m = 0; m < 4; ++m) {
                    bf16_t* rowp = O + (size_t)(row0 + ai * HALF + m * 16) * ldo + col0; const float s1 = sc[ai][m];
#pragma unroll
                    for (int bj = 0; bj < 2; ++bj) { f32x4 v0 = acc[ai][bj][m][0] * s1, v1 = acc[ai][bj][m][1] * s1;
                        if constexpr (MODE == 1) {
#pragma unroll
                            for (int e = 0; e < 4; ++e) { const float a = fmaxf(v0[e], 0.f), b = fmaxf(v1[e], 0.f); v0[e] = a * a; v1[e] = b * b; } }
                        u32x4 w; w.x = cvt_pk_bf16(v0[0], v0[1]); w.y = cvt_pk_bf16(v0[2], v0[3]); w.z = cvt_pk_bf16(v1[0], v1[1]); w.w = cvt_pk_bf16(v1[2], v1[3]);
                        *(u32x4*)(rowp + bj * HALF) = w; }
                }
        } else if constexpr (MODE == 4) {
            u32x4 bw[2][4][2];
#pragma unroll
            for (int ai = 0; ai < 2; ++ai)
#pragma unroll
                for (int m = 0; m < 4; ++m)
#pragma unroll
                    for (int bj = 0; bj < 2; ++bj) bw[ai][m][bj] = *(const u32x4*)(pp + (size_t)(row0 + ai * HALF + m * 16) * 1024 + col0 + bj * HALF);
#pragma unroll
            for (int ai = 0; ai < 2; ++ai)
#pragma unroll
                for (int m = 0; m < 4; ++m) {
                    const int row = row0 + ai * HALF + m * 16; bf16_t* xp = O + (size_t)row * 1024 + col0; float q = 0.f;
#pragma unroll
                    for (int bj = 0; bj < 2; ++bj) { f32x4 b0, b1; unpack_bf16x8(bw[ai][m][bj], b0, b1);
                        const f32x4 v0 = acc[ai][bj][m][0] + b0, v1 = acc[ai][bj][m][1] + b1;
                        q += (v0[0] * v0[0] + v0[1] * v0[1]) + (v0[2] * v0[2] + v0[3] * v0[3]) + (v1[0] * v1[0] + v1[1] * v1[1]) + (v1[2] * v1[2] + v1[3] * v1[3]);
                        u32x4 w; w.x = cvt_pk_bf16(v0[0], v0[1]); w.y = cvt_pk_bf16(v0[2], v0[3]); w.z = cvt_pk_bf16(v1[0], v1[1]); w.w = cvt_pk_bf16(v1[2], v1[3]);
                        *(u32x4*)(xp + bj * HALF) = w; }
                    q += __shfl_xor(q, 16); q += __shfl_xor(q, 32);
                    if (fq == 0) sspo[(size_t)row * 16 + u.pn * 4 + wc] = q;
                }
        } else {
            u32x4 xw[4][2][2], pw[4][2][2];
#define EPI3_LOAD(b) do { _Pragma("unroll") for (int r = 0; r < 2; ++r) { const int row = row0 + ((b) >> 1) * HALF + (((b) & 1) * 2 + r) * 16; \
                _Pragma("unroll") for (int bj = 0; bj < 2; ++bj) { xw[b][r][bj] = __builtin_nontemporal_load((const u32x4*)(O + (size_t)row * 1024 + col0 + bj * HALF)); pw[b][r][bj] = __builtin_nontemporal_load((const u32x4*)(pp + (size_t)row * 1024 + col0 + bj * HALF)); } } } while (0)
#define EPI3_DO(b) do { _Pragma("unroll") for (int r = 0; r < 2; ++r) { const int ai = (b) >> 1, m = ((b) & 1) * 2 + r; const int row = row0 + ai * HALF + m * 16; float* op = out + (size_t)row * 1024 + col0; const float s1 = sc[ai][m]; \
                _Pragma("unroll") for (int bj = 0; bj < 2; ++bj) { f32x4 x0, x1, p0, p1; unpack_bf16x8(xw[b][r][bj], x0, x1); unpack_bf16x8(pw[b][r][bj], p0, p1); f32x4 v0, v1; \
                    _Pragma("unroll") for (int e = 0; e < 4; ++e) { const float g0 = 1.0f / (1.0f + __expf(-acc[ai][bj][m][0][e] * s1)), g1 = 1.0f / (1.0f + __expf(-acc[ai][bj][m][1][e] * s1)); v0[e] = x0[e] + g0 * p0[e]; v1[e] = x1[e] + g1 * p1[e]; } \
                    __builtin_nontemporal_store(v0, (f32x4*)(op + bj * HALF)); __builtin_nontemporal_store(v1, (f32x4*)(op + bj * HALF + 4)); } } } while (0)
            EPI3_LOAD(0); EPI3_LOAD(1); EPI3_DO(0); EPI3_LOAD(2); EPI3_DO(1); EPI3_LOAD(3); EPI3_DO(2); EPI3_DO(3);
#undef EPI3_LOAD
#undef EPI3_DO
        }
    }
};

template <class Epi, class Sched, bool ALIGN_EPI = false, bool SP2 = false>
__device__ __forceinline__ void gemm_phase(PG8_LAS unsigned char* lds, const Gemm g, const Sched& S, const Epi& E) {
    const int tid = opaque_tid(), wid = __builtin_amdgcn_readfirstlane(tid >> 6), lane = tid & 63, wr = wid >> 2, wc = wid & 3, fr = lane & 15, fq = lane >> 4;
    const int K = g.K, nt = K / BK;
    unsigned voffA[2], voffB[2];
#pragma unroll
    for (int i = 0; i < 2; ++i) { int R, C; stage_rc(tid * 16 + i * 8192, R, C); const int Rb = Epi::PERM ? ((R & ~31) + perm32(R & 31)) : R;
        voffA[i] = (unsigned)(R * K + C) * 2u; voffB[i] = (unsigned)(Rb * K + C) * 2u; }
    const size_t kstep = (size_t)(BK * 2);
    const size_t hstep = (size_t)HALF * K * 2;
    const size_t tstep = 2 * hstep;
    const unsigned ldsw = (unsigned)wid * 1024u;
    const int aoff = lds_byte(wr * 64 + fr, fq * 8), boff = lds_byte(wc * 32 + fr, fq * 8);
#define PG8_SA(b, h) (((b) * 2 + (h)) * HTB)
#define PG8_SB(b, h) ((4 + (b) * 2 + (h)) * HTB)
#define PG8_STAGE(bufoff, gbase, voff) do { _Pragma("unroll") for (int _i = 0; _i < 2; ++_i) \
        __builtin_amdgcn_global_load_lds((const unsigned*)((const char*)(gbase) + (voff)[_i]), (PG8_LAS unsigned*)(lds + (bufoff) + ldsw + _i * 8192), 16, 0, 0); } while (0)
#define PG8_LDA(dst, b, h) do { _Pragma("unroll") for (int m = 0; m < 4; ++m) _Pragma("unroll") for (int k = 0; k < 2; ++k) dst[m][k] = *(const PG8_LAS bf16x8*)(lds + PG8_SA(b, h) + aoff + m * 2048 + k * 1024); } while (0)
#define PG8_LDB(dst, b, h) do { _Pragma("unroll") for (int n = 0; n < 2; ++n) _Pragma("unroll") for (int k = 0; k < 2; ++k) dst[n][k] = *(const PG8_LAS bf16x8*)(lds + PG8_SB(b, h) + boff + n * 2048 + k * 1024); } while (0)
#define PG8_MMA(ai, bj, At, Bt) do { __builtin_amdgcn_s_setprio(1); _Pragma("unroll") for (int m = 0; m < 4; ++m) _Pragma("unroll") for (int n = 0; n < 2; ++n) _Pragma("unroll") for (int k = 0; k < 2; ++k) \
        acc[ai][bj][m][n] = __builtin_amdgcn_mfma_f32_16x16x32_bf16(Bt[n][k], At[m][k], acc[ai][bj][m][n], 0, 0, 0); __builtin_amdgcn_s_setprio(0); } while (0)
#define PG8_WAIT_V(n) asm volatile("s_waitcnt vmcnt(" #n ")" ::: "memory")
#define PG8_WAIT_L(n) asm volatile("s_waitcnt lgkmcnt(" #n ")" ::: "memory")
#define PG8_BAR __builtin_amdgcn_s_barrier()
#define PG8_SCHED __builtin_amdgcn_sched_barrier(0)
    Unit cur, nxt; int ui = 0;
    if (!S.next(0, cur)) return;
    f32x4 acc[2][2][4][2];
#pragma unroll
    for (int a = 0; a < 2; ++a)
#pragma unroll
        for (int b = 0; b < 2; ++b)
#pragma unroll
            for (int m = 0; m < 4; ++m)
#pragma unroll
                for (int n = 0; n < 2; ++n) acc[a][b][m][n] = (f32x4){0.f, 0.f, 0.f, 0.f};
    bf16x8 At[4][2], B0[2][2], B1[2][2];
    const char* cA = (const char*)g.A + (size_t)cur.pm * tstep; const char* cB = (const char*)g.Bt + (size_t)cur.pn * tstep;
    S.a_ready(cur);
    if constexpr (SP2) {
        PG8_STAGE(PG8_SB(0, 0), cB, voffB); PG8_STAGE(PG8_SB(0, 1), cB + hstep, voffB); PG8_STAGE(PG8_SA(0, 0), cA, voffA); PG8_STAGE(PG8_SA(0, 1), cA + hstep, voffA);
        if (wr == 1) PG8_BAR;
        PG8_WAIT_V(2); PG8_BAR;
        PG8_STAGE(PG8_SB(1, 0), cB + kstep, voffB); PG8_STAGE(PG8_SA(1, 0), cA + kstep, voffA); PG8_STAGE(PG8_SB(1, 1), cB + hstep + kstep, voffB);
        PG8_WAIT_V(6); PG8_BAR;
    } else {
        PG8_STAGE(PG8_SB(0, 0), cB, voffB); PG8_STAGE(PG8_SA(0, 0), cA, voffA); PG8_STAGE(PG8_SB(0, 1), cB + hstep, voffB); PG8_STAGE(PG8_SA(0, 1), cA + hstep, voffA);
        if (wr == 1) PG8_BAR;
        PG8_WAIT_V(4); PG8_BAR;
        PG8_STAGE(PG8_SB(1, 0), cB + kstep, voffB); PG8_STAGE(PG8_SA(1, 0), cA + kstep, voffA); PG8_STAGE(PG8_SB(1, 1), cB + hstep + kstep, voffB);
        PG8_WAIT_V(6); PG8_BAR;
    }
    for (;;) {
        const bool has_next = S.next(ui + 1, nxt);
        const char* nA = has_next ? (const char*)g.A + (size_t)nxt.pm * tstep : cA; const char* nB = has_next ? (const char*)g.Bt + (size_t)nxt.pn * tstep : cB;
        for (int t = 0; t < nt; t += 2) {
            const bool last = (t == nt - 2);
            const char* a1 = cA + (size_t)(t + 1) * kstep;
            const char* a2 = last ? nA : cA + (size_t)(t + 2) * kstep; const char* b2 = last ? nB : cB + (size_t)(t + 2) * kstep;
            const char* a3 = a2 + kstep; const char* b3 = b2 + kstep;
            if (last && has_next) S.a_ready(nxt);
            if constexpr (SP2) {
            PG8_LDB(B0, 0, 0); PG8_LDB(B1, 0, 1); PG8_SCHED; PG8_LDA(At, 0, 0); PG8_STAGE(PG8_SA(1, 1), a1 + hstep, voffA);
            PG8_WAIT_V(8); PG8_WAIT_L(0); PG8_BAR; PG8_MMA(0, 0, At, B0); PG8_MMA(0, 1, At, B1); PG8_BAR; PG8_SCHED;
            PG8_LDA(At, 0, 1); PG8_STAGE(PG8_SB(0, 0), b2, voffB); PG8_STAGE(PG8_SB(0, 1), b2 + hstep, voffB); PG8_STAGE(PG8_SA(0, 0), a2, voffA);
            PG8_WAIT_V(8); PG8_WAIT_L(0); PG8_BAR; PG8_MMA(1, 0, At, B0); PG8_MMA(1, 1, At, B1); PG8_BAR; PG8_SCHED;
            PG8_LDB(B0, 1, 0); PG8_LDB(B1, 1, 1); PG8_SCHED; PG8_LDA(At, 1, 0); PG8_STAGE(PG8_SA(0, 1), a2 + hstep, voffA);
            PG8_WAIT_V(8); PG8_WAIT_L(0); PG8_BAR; PG8_MMA(0, 0, At, B0); PG8_MMA(0, 1, At, B1); PG8_BAR; PG8_SCHED;
            PG8_LDA(At, 1, 1); PG8_STAGE(PG8_SB(1, 0), b3, voffB); PG8_STAGE(PG8_SB(1, 1), b3 + hstep, voffB); PG8_STAGE(PG8_SA(1, 0), a3, voffA);
            PG8_WAIT_V(8); PG8_WAIT_L(0); PG8_BAR; PG8_MMA(1, 0, At, B0); PG8_MMA(1, 1, At, B1); PG8_BAR; PG8_SCHED;
            } else {
            PG8_LDB(B0, 0, 0); PG8_SCHED; PG8_LDA(At, 0, 0); PG8_STAGE(PG8_SA(1, 1), a1 + hstep, voffA);
            PG8_WAIT_L(8); PG8_BAR; PG8_WAIT_L(0); PG8_MMA(0, 0, At, B0); PG8_BAR; PG8_SCHED;
            PG8_LDB(B1, 0, 1); PG8_STAGE(PG8_SB(0, 0), b2, voffB);
            PG8_BAR; PG8_WAIT_L(0); PG8_MMA(0, 1, At, B1); PG8_BAR;
            PG8_LDA(At, 0, 1); PG8_STAGE(PG8_SA(0, 0), a2, voffA);
            PG8_BAR; PG8_WAIT_L(0); PG8_MMA(1, 0, At, B0); PG8_BAR; PG8_SCHED;
            PG8_STAGE(PG8_SB(0, 1), b2 + hstep, voffB);
            PG8_WAIT_V(6); PG8_BAR; PG8_MMA(1, 1, At, B1); PG8_BAR;
            PG8_LDB(B0, 1, 0); PG8_SCHED; PG8_LDA(At, 1, 0); PG8_STAGE(PG8_SA(0, 1), a2 + hstep, voffA);
            PG8_WAIT_L(8); PG8_BAR; PG8_WAIT_L(0); PG8_MMA(0, 0, At, B0); PG8_BAR; PG8_SCHED;
            PG8_LDB(B1, 1, 1); PG8_STAGE(PG8_SB(1, 0), b3, voffB);
            PG8_BAR; PG8_WAIT_L(0); PG8_MMA(0, 1, At, B1); PG8_BAR;
            PG8_LDA(At, 1, 1); PG8_STAGE(PG8_SA(1, 0), a3, voffA);
            PG8_BAR; PG8_WAIT_L(0); PG8_MMA(1, 0, At, B0); PG8_BAR; PG8_SCHED;
            PG8_STAGE(PG8_SB(1, 1), b3 + hstep, voffB);
            PG8_WAIT_V(6); PG8_BAR; PG8_MMA(1, 1, At, B1); PG8_BAR;
            }
        }
        if constexpr (ALIGN_EPI) { if (wr == 0) PG8_BAR; }
        if constexpr (!Epi::AFTER_DRAIN) { E(acc, cur, wr, wc, fr, fq); S.done(cur); }
        if (!has_next) break;
#pragma unroll
        for (int a = 0; a < 2; ++a)
#pragma unroll
            for (int b = 0; b < 2; ++b)
#pragma unroll
                for (int m = 0; m < 4; ++m)
#pragma unroll
                    for (int n = 0; n < 2; ++n) acc[a][b][m][n] = (f32x4){0.f, 0.f, 0.f, 0.f};
        cur = nxt; cA = nA; cB = nB; ++ui;
        if constexpr (ALIGN_EPI) { if (wr == 1) PG8_BAR; }
    }
    PG8_WAIT_V(0);
    if constexpr (!ALIGN_EPI) { if (wr == 0) PG8_BAR; }
    PG8_BAR;
    if constexpr (Epi::AFTER_DRAIN) { E.fused(acc, cur, wr, wc, fr, fq, lds, wid, lane); S.done(cur); }
#undef PG8_SA
#undef PG8_SB
#undef PG8_STAGE
#undef PG8_LDA
#undef PG8_LDB
#undef PG8_MMA
#undef PG8_WAIT_V
#undef PG8_WAIT_L
#undef PG8_BAR
#undef PG8_SCHED
}
}
#define LAS __attribute__((address_space(3)))
typedef unsigned short bf16;
typedef unsigned v4u __attribute__((ext_vector_type(4)));
typedef unsigned v2u __attribute__((ext_vector_type(2)));
typedef float f32x4 __attribute__((ext_vector_type(4)));
typedef short s16x8 __attribute__((ext_vector_type(8)));
typedef short s16x4 __attribute__((ext_vector_type(4)));

constexpr int D = 1024, MP = 16384, MS = 512, M = MP + MS, NIN = 2304, FF = 4096, PLE = 256, SEQ = 2048, NWAVES = 8;
constexpr float EPS = 1e-6f;
constexpr float LOG2E = 1.4426950408889634f;
constexpr size_t MiB = 1u << 20;
constexpr size_t WS_RSTD0 = 0, WS_BAR = 96 * 1024, WS_BAR_BYTES = 16 * 1024, WS_ROPE = 128 * 1024, WS_SS1 = 1 * MiB, WS_SS2 = 3 * MiB;
constexpr size_t WS_WIN = 6 * MiB, WS_WO = WS_WIN + (size_t)NIN * D * 2, WS_WUP = WS_WO + 2 * MiB, WS_WDN = WS_WUP + 8 * MiB, WS_WG = WS_WDN + 8 * MiB, WS_WP = WS_WG + 2 * MiB;
constexpr size_t WS_PB = 31 * MiB, WS_U = 40 * MiB, WS_Z = 40 * MiB, WS_XB = 115 * MiB, WS_PPB = 40 * MiB, WS_X1B = 172 * MiB, WS_MIXED = 205 * MiB, WS_X2B = 205 * MiB, WS_END = 238 * MiB;
static_assert(WS_WP + (size_t)D * PLE * 2 <= WS_PB && WS_PB + (size_t)M * PLE * 2 <= WS_U && WS_Z + (size_t)M * NIN * 2 <= WS_XB && WS_XB + (size_t)M * D * 2 <= WS_X1B && WS_U + (size_t)M * FF * 2 <= WS_X1B && WS_X1B + (size_t)M * D * 2 <= WS_MIXED && WS_MIXED + (size_t)M * D * 2 <= WS_END, "ws map");
static_assert(WS_ROPE + 2052 * 64 * 4 <= WS_SS1 && WS_SS1 + (size_t)M * 64 <= WS_SS2 && WS_SS2 + (size_t)M * 64 <= WS_WIN, "ws map (small)");
constexpr size_t OFF_YP = 0, OFF_YS = (size_t)MP * D, OFF_KP = OFF_YS + (size_t)MS * D, OFF_VP = OFF_KP + 8 * 128 * 128, OFF_CP = OFF_VP + 8 * 128 * 128,
                 OFF_KS = OFF_CP + 8 * 2 * 512, OFF_VS = OFF_KS + 128 * 128 * 128, OFF_CS = OFF_VS + 128 * 128 * 128, OUT_TOTAL = OFF_CS + 128 * 2 * 512;
constexpr int LDS_BYTES = 147456;

#define LDS_WAIT() asm volatile("s_waitcnt lgkmcnt(0)" ::: "memory")
__device__ __forceinline__ unsigned pk2(float lo, float hi) { return pg8::cvt_pk_bf16(lo, hi); }
__device__ __forceinline__ float bflo(unsigned w) { return __uint_as_float(w << 16); }
__device__ __forceinline__ float bfhi(unsigned w) { return __uint_as_float(w & 0xffff0000u); }
__device__ __forceinline__ void unpack8(const v4u w, float (&x)[8]) { x[0] = bflo(w.x); x[1] = bfhi(w.x); x[2] = bflo(w.y); x[3] = bfhi(w.y); x[4] = bflo(w.z); x[5] = bfhi(w.z); x[6] = bflo(w.w); x[7] = bfhi(w.w); }
__device__ __forceinline__ v4u pack8(const float (&x)[8]) { v4u o; o.x = pk2(x[0], x[1]); o.y = pk2(x[2], x[3]); o.z = pk2(x[4], x[5]); o.w = pk2(x[6], x[7]); return o; }
__device__ __forceinline__ float wave_sum(float v) {
#pragma unroll
    for (int o = 1; o < 64; o <<= 1) v += __shfl_xor(v, o);
    return v;
}

struct Args { const float* in[22]; float* out; unsigned char* ws; int ph_lo, ph_hi; };

__device__ __forceinline__ void p0_transpose_item(const float* W, int K, int N, bf16* WT, const float* g, LAS float* scr, int k0, int n0, int lane) {
    const int r8 = lane >> 3, c4 = (lane & 7) * 4;
    f32x4 v[8];
#pragma unroll
    for (int i = 0; i < 8; ++i) v[i] = __builtin_nontemporal_load((const f32x4*)(W + (size_t)(k0 + 8 * i + r8) * N + n0 + c4));
#pragma unroll
    for (int i = 0; i < 8; ++i) { const int kk = 8 * i + r8; const float gv = g ? g[kk] : 1.0f; LAS float* d = scr + kk * 33 + c4;
        d[0] = v[i][0] * gv; d[1] = v[i][1] * gv; d[2] = v[i][2] * gv; d[3] = v[i][3] * gv; }
    LDS_WAIT(); asm volatile("" ::: "memory");
    const int c = lane & 7;
#pragma unroll
    for (int j = 0; j < 4; ++j) { const int n = (lane >> 3) + 8 * j; const LAS float* s = scr + (8 * c) * 33 + n;
        v4u o; o.x = pk2(s[0 * 33], s[1 * 33]); o.y = pk2(s[2 * 33], s[3 * 33]); o.z = pk2(s[4 * 33], s[5 * 33]); o.w = pk2(s[6 * 33], s[7 * 33]);
        *(v4u*)(WT + (size_t)(n0 + n) * K + k0 + 8 * c) = o; }
    LDS_WAIT(); asm volatile("" ::: "memory");
}
constexpr int P1_LIGHT0 = 82;
__device__ __forceinline__ void p0_weights(const Args& a, LAS unsigned char* lds, int set, int gw, int NGW, int it_end = 1 << 30) {
    const int lane = opaque_tid() & 63, wave = __builtin_amdgcn_readfirstlane(opaque_tid() >> 6);
    unsigned char* ws = a.ws;
    LAS float* scr = (LAS float*)(lds + wave * 16384);
    constexpr int I_IN = 16 * (NIN / 32), I_O = 16 * 32, I_UP = 16 * (FF / 32), I_DN = 64 * 32, I_G = 16 * 32, I_P = 4 * 32;
    const int nitems = set == 0 ? I_IN + I_O + I_P : I_UP + I_DN + I_G;
    const int itend = it_end < nitems ? it_end : nitems;
    for (int it = gw; it < itend; it += NGW) {
        int r = it; const float* W; const float* g; bf16* WT; int K, N;
        if (set == 0) {
            if (r < I_IN) { W = a.in[8]; g = a.in[7]; WT = (bf16*)(ws + WS_WIN); K = D; N = NIN; }
            else if ((r -= I_IN) < I_O) { W = a.in[15]; g = nullptr; WT = (bf16*)(ws + WS_WO); K = D; N = D; }
            else { r -= I_O; W = a.in[21]; g = nullptr; WT = (bf16*)(ws + WS_WP); K = PLE; N = D; }
        } else {
            if (r < I_UP) { W = a.in[17]; g = a.in[16]; WT = (bf16*)(ws + WS_WUP); K = D; N = FF; }
            else if ((r -= I_UP) < I_DN) { W = a.in[18]; g = nullptr; WT = (bf16*)(ws + WS_WDN); K = FF; N = D; }
            else { r -= I_DN; W = a.in[20]; g = a.in[19]; WT = (bf16*)(ws + WS_WG); K = D; N = D; }
        }
        const int nblk = N / 32, k0 = 64 * (r / nblk), n0 = 32 * (r % nblk);
        if (W == a.in[15]) g = (k0 < 512) ? a.in[13] + k0 : a.in[14] + (k0 - 512); else if (g) g += k0;
        p0_transpose_item(W, K, N, WT, g, scr, k0, n0, lane);
    }
}
__device__ __forceinline__ void p0_prologue(const Args& a, LAS unsigned char* lds, int G) {
    const int tid = opaque_tid(), lane = tid & 63, wave = __builtin_amdgcn_readfirstlane(tid >> 6);
    unsigned char* ws = a.ws;
    const int gw = opaque_bid() * NWAVES + wave, NGW = G * NWAVES;
    p0_weights(a, lds, 0, gw, NGW);
    float* rstd0 = (float*)(ws + WS_RSTD0); bf16* XB = (bf16*)(ws + WS_XB); bf16* PB = (bf16*)(ws + WS_PB);
    for (int m0 = 2 * gw; m0 < M; m0 += 2 * NGW) {
        f32x4 v[2][4]; f32x4 pv[2];
#pragma unroll
        for (int h = 0; h < 2; ++h) { const int m = m0 + h;
            const float* xrow = m < MP ? a.in[0] + (size_t)m * D : a.in[1] + (size_t)(m - MP) * D; const f32x4* xr = (const f32x4*)xrow + lane;
#pragma unroll
            for (int j = 0; j < 4; ++j) v[h][j] = __builtin_nontemporal_load(xr + 64 * j);
            const float* prow = m < MP ? a.in[2] + (size_t)m * PLE : a.in[3] + (size_t)(m - MP) * PLE; pv[h] = __builtin_nontemporal_load((const f32x4*)prow + lane); }
#pragma unroll
        for (int h = 0; h < 2; ++h) { const int m = m0 + h; float s = 0.f;
#pragma unroll
            for (int j = 0; j < 4; ++j) s += (v[h][j].x * v[h][j].x + v[h][j].y * v[h][j].y) + (v[h][j].z * v[h][j].z + v[h][j].w * v[h][j].w);
            s = wave_sum(s);
            if (lane == 0) rstd0[m] = rsqrtf(s * (1.0f / D) + EPS);
            v2u* o8 = (v2u*)(XB + (size_t)m * D) + lane;
#pragma unroll
            for (int j = 0; j < 4; ++j) { v2u o; o.x = pk2(v[h][j].x, v[h][j].y); o.y = pk2(v[h][j].z, v[h][j].w); o8[64 * j] = o; }
            v2u po; po.x = pk2(pv[h].x, pv[h].y); po.y = pk2(pv[h].z, pv[h].w); ((v2u*)(PB + (size_t)m * PLE))[lane] = po; }
    }
    float* rope = (float*)(ws + WS_ROPE);
    for (int idx = opaque_bid() * 512 + tid; idx < 2052 * 32; idx += G * 512) {
        const int pi = idx >> 5, i = idx & 31; const int pos = pi < 2048 ? pi : 16384 + (pi - 2048);
        const float inv_freq = exp2f(-(float)i * 0.41524101186092029f);
        const float ang = (float)pos * inv_freq;
        const double rev = (double)ang * 0.15915494309189535; const float fr = (float)(rev - floor(rev));
        rope[pi * 64 + i] = __builtin_amdgcn_cosf(fr); rope[pi * 64 + 32 + i] = __builtin_amdgcn_sinf(fr);
    }
}
constexpr int KST = 72, VST = 200, KROWS = 192;
constexpr int MX_KS = 0, MX_VT = 2 * KROWS * KST * 2, MX_RED = MX_VT + 2 * 64 * VST * 2;
static_assert(MX_RED + 64 * 8 * 4 <= 131072, "mixer LDS");

__device__ __forceinline__ void k_norm_rope(float (&x)[8], int j, const float* g, const float* rp) {
    float ss = 0.f;
#pragma unroll
    for (int e = 0; e < 8; ++e) ss += x[e] * x[e];
    ss += __shfl_xor(ss, 1); ss += __shfl_xor(ss, 2); ss += __shfl_xor(ss, 4);
    const float rstd = rsqrtf(ss * (1.0f / 64.0f) + EPS);
    const f32x4 g0 = *(const f32x4*)(g + 8 * j), g1 = *(const f32x4*)(g + 8 * j + 4);
    const int i0 = 8 * (j & 3);
    const f32x4 c0 = *(const f32x4*)(rp + i0), c1 = *(const f32x4*)(rp + i0 + 4), s0 = *(const f32x4*)(rp + 32 + i0), s1 = *(const f32x4*)(rp + 32 + i0 + 4);
    const float sg = (j < 4) ? -1.0f : 1.0f;
#pragma unroll
    for (int e = 0; e < 8; ++e) {
        const float y = x[e] * rstd * (e < 4 ? g0[e & 3] : g1[e & 3]);
        const float p = __shfl_xor(y, 4);
        const float c = e < 4 ? c0[e & 3] : c1[e & 3], s = e < 4 ? s0[e & 3] : s1[e & 3];
        x[e] = y * c + sg * p * s;
    }
}
__device__ __forceinline__ void q_frag_raw(const v4u w0, const v4u w1, const float* gq, const float* rp, int fq, s16x8& q0, s16x8& q1) {
    float x0[8], x1[8]; unpack8(w0, x0); unpack8(w1, x1);
    float ss = 0.f;
#pragma unroll
    for (int e = 0; e < 8; ++e) ss += x0[e] * x0[e] + x1[e] * x1[e];
    ss += __shfl_xor(ss, 16); ss += __shfl_xor(ss, 32);
    const float rstd = rsqrtf(ss * (1.0f / 64.0f) + EPS) * (LOG2E * 0.125f);
    const f32x4 ga = *(const f32x4*)(gq + 8 * fq), gb = *(const f32x4*)(gq + 8 * fq + 4), gc = *(const f32x4*)(gq + 32 + 8 * fq), gd = *(const f32x4*)(gq + 36 + 8 * fq);
    const f32x4 ca = *(const f32x4*)(rp + 8 * fq), cb = *(const f32x4*)(rp + 8 * fq + 4), sa = *(const f32x4*)(rp + 32 + 8 * fq), sb = *(const f32x4*)(rp + 36 + 8 * fq);
    float o0[8], o1[8];
#pragma unroll
    for (int e = 0; e < 8; ++e) {
        const float y0 = x0[e] * rstd * (e < 4 ? ga[e & 3] : gb[e & 3]), y1 = x1[e] * rstd * (e < 4 ? gc[e & 3] : gd[e & 3]);
        const float c = e < 4 ? ca[e & 3] : cb[e & 3], sn = e < 4 ? sa[e & 3] : sb[e & 3];
        o0[e] = y0 * c - y1 * sn; o1[e] = y1 * c + y0 * sn;
    }
    const v4u p0 = pack8(o0), p1 = pack8(o1);
    q0 = __builtin_bit_cast(s16x8, p0); q1 = __builtin_bit_cast(s16x8, p1);
}
__device__ __forceinline__ void q_frag(const bf16* zq  , const float* gq, const float* rp, int fq, s16x8& q0, s16x8& q1) {
    const v4u w0 = *(const v4u*)(zq + 8 * fq), w1 = *(const v4u*)(zq + 32 + 8 * fq);
    q_frag_raw(w0, w1, gq, rp, fq, q0, q1);
}
__device__ __forceinline__ void attn_strip(const LAS bf16* Ks, const LAS bf16* Vt, const s16x8 q0, const s16x8 q1, int tl, int jmin, float sink2, int fr, int fq, f32x4 (&O)[4]) {
    f32x4 S[9];
#pragma unroll
    for (int kt = 0; kt < 9; ++kt) {
        const LAS bf16* kp = Ks + (16 * kt + fr) * KST + 8 * fq;
        const s16x8 a0 = *(const LAS s16x8*)kp, a1 = *(const LAS s16x8*)(kp + 32);
        f32x4 c = {0.f, 0.f, 0.f, 0.f};
        c = __builtin_amdgcn_mfma_f32_16x16x32_bf16(a0, q0, c, 0, 0, 0);
        c = __builtin_amdgcn_mfma_f32_16x16x32_bf16(a1, q1, c, 0, 0, 0);
        S[kt] = c;
    }
    float mx = sink2;
#pragma unroll
    for (int i = 0; i < 4; ++i) { const int j0 = 4 * fq + i; if (!(j0 > tl)) S[0][i] = -1e30f; if (!(j0 <= tl)) S[8][i] = -1e30f; }
    if (jmin > 0) {
#pragma unroll
        for (int kt = 0; kt < 9; ++kt)
#pragma unroll
            for (int i = 0; i < 4; ++i) if (16 * kt + 4 * fq + i < jmin) S[kt][i] = -1e30f;
    }
#pragma unroll
    for (int kt = 0; kt < 9; ++kt)
#pragma unroll
        for (int i = 0; i < 4; ++i) mx = fmaxf(mx, S[kt][i]);
    mx = fmaxf(mx, __shfl_xor(mx, 16)); mx = fmaxf(mx, __shfl_xor(mx, 32));
    float sum = 0.f;
#pragma unroll
    for (int kt = 0; kt < 9; ++kt)
#pragma unroll
        for (int i = 0; i < 4; ++i) { const float e = __builtin_amdgcn_exp2f(S[kt][i] - mx); S[kt][i] = e; sum += e; }
    sum += __shfl_xor(sum, 16); sum += __shfl_xor(sum, 32);
    const float inv = 1.0f / (sum + __builtin_amdgcn_exp2f(sink2 - mx));
#pragma unroll
    for (int dt = 0; dt < 4; ++dt) O[dt] = (f32x4){0.f, 0.f, 0.f, 0.f};
#pragma unroll
    for (int p = 0; p < 4; ++p) {
        v4u pw; pw.x = pk2(S[2 * p][0] * inv, S[2 * p][1] * inv); pw.y = pk2(S[2 * p][2] * inv, S[2 * p][3] * inv); pw.z = pk2(S[2 * p + 1][0] * inv, S[2 * p + 1][1] * inv); pw.w = pk2(S[2 * p + 1][2] * inv, S[2 * p + 1][3] * inv);
        const s16x8 pb = __builtin_bit_cast(s16x8, pw);
#pragma unroll
        for (int dt = 0; dt < 4; ++dt) {
            const LAS bf16* vp = Vt + (16 * dt + fr) * VST + 32 * p + 4 * fq;
            const v2u lo = *(const LAS v2u*)vp, hi = *(const LAS v2u*)(vp + 16);
            const v4u va4 = (v4u){lo.x, lo.y, hi.x, hi.y};
            O[dt] = __builtin_amdgcn_mfma_f32_16x16x32_bf16(__builtin_bit_cast(s16x8, va4), pb, O[dt], 0, 0, 0);
        }
    }
    {
        v2u pw; pw.x = pk2(S[8][0] * inv, S[8][1] * inv); pw.y = pk2(S[8][2] * inv, S[8][3] * inv);
        const s16x4 pb = __builtin_bit_cast(s16x4, pw);
#pragma unroll
        for (int dt = 0; dt < 4; ++dt) {
            const s16x4 va = *(const LAS s16x4*)(Vt + (16 * dt + fr) * VST + 128 + 4 * fq);
            O[dt] = __builtin_amdgcn_mfma_f32_16x16x16bf16_1k(va, pb, O[dt], 0, 0, 0);
        }
    }
}
__device__ __forceinline__ void load_u(int mode, const bf16* z, size_t zrow, const float* st, int ch, float (&u)[8]) {
    if (mode == 1) { const v4u c = *(const v4u*)(z + zrow * NIN + 1280 + ch), h = *(const v4u*)(z + zrow * NIN + 1792 + ch); float a[8], b[8]; unpack8(c, a); unpack8(h, b);
#pragma unroll
        for (int e = 0; e < 8; ++e) u[e] = a[e] * b[e]; }
    else if (mode == 2) { const f32x4 a = *(const f32x4*)(st + ch), b = *(const f32x4*)(st + ch + 4); u[0] = a[0]; u[1] = a[1]; u[2] = a[2]; u[3] = a[3]; u[4] = b[0]; u[5] = b[1]; u[6] = b[2]; u[7] = b[3]; }
    else {
#pragma unroll
        for (int e = 0; e < 8; ++e) u[e] = 0.f; }
}
__device__ __forceinline__ void conv_token(const bf16* z, bf16* mixed, const float* convw, size_t row, int m1, size_t r1, const float* s1, int m2, size_t r2, const float* s2, float* u0out, int lane) {
    const int ch = 8 * lane; float u0[8], u1[8], u2[8];
    load_u(1, z, row, nullptr, ch, u0); load_u(m1, z, r1, s1, ch, u1); load_u(m2, z, r2, s2, ch, u2);
    const v4u bw = *(const v4u*)(z + row * NIN + 768 + ch); float bg[8]; unpack8(bw, bg);
    float w0[8], w1[8], w2[8];
#pragma unroll
    for (int h = 0; h < 2; ++h) { const f32x4 a = *(const f32x4*)(convw + ch + 4 * h), b = *(const f32x4*)(convw + 512 + ch + 4 * h), c = *(const f32x4*)(convw + 1024 + ch + 4 * h);
#pragma unroll
        for (int e = 0; e < 4; ++e) { w0[4 * h + e] = a[e]; w1[4 * h + e] = b[e]; w2[4 * h + e] = c[e]; } }
    float o[8]; float ss = 0.f;
#pragma unroll
    for (int e = 0; e < 8; ++e) { o[e] = bg[e] * (w0[e] * u2[e] + w1[e] * u1[e] + w2[e] * u0[e]); ss += o[e] * o[e]; }
    ss = wave_sum(ss);
    const float rstd = rsqrtf(ss * (1.0f / 512.0f) + EPS);
#pragma unroll
    for (int e = 0; e < 8; ++e) o[e] *= rstd;
    *(v4u*)(mixed + row * D + 512 + ch) = pack8(o);
    if (u0out) { *(f32x4*)(u0out + ch) = (f32x4){u0[0], u0[1], u0[2], u0[3]}; *(f32x4*)(u0out + ch + 4) = (f32x4){u0[4], u0[5], u0[6], u0[7]}; }
}

__device__ __forceinline__ void conv_tokens4(const bf16* z, bf16* mixed, const float* convw, size_t row0, int t, float* cp_out  , int lane) {
    const int ch = 8 * lane;
    v4u cw[6], hw[6], bw[4];
#pragma unroll
    for (int i = 0; i < 6; ++i) { const bool ok = (t + i - 2) >= 0; const size_t r = ok ? row0 + i - 2 : row0; cw[i] = *(const v4u*)(z + r * NIN + 1280 + ch); hw[i] = *(const v4u*)(z + r * NIN + 1792 + ch);
        if (!ok) { cw[i] = (v4u){0u, 0u, 0u, 0u}; } }
#pragma unroll
    for (int i = 0; i < 4; ++i) bw[i] = *(const v4u*)(z + (row0 + i) * NIN + 768 + ch);
    float w0[8], w1[8], w2[8];
#pragma unroll
    for (int h = 0; h < 2; ++h) { const f32x4 a = *(const f32x4*)(convw + ch + 4 * h), b = *(const f32x4*)(convw + 512 + ch + 4 * h), c = *(const f32x4*)(convw + 1024 + ch + 4 * h);
#pragma unroll
        for (int e = 0; e < 4; ++e) { w0[4 * h + e] = a[e]; w1[4 * h + e] = b[e]; w2[4 * h + e] = c[e]; } }
    float u[6][8];
#pragma unroll
    for (int i = 0; i < 6; ++i) { float a[8], b[8]; unpack8(cw[i], a); unpack8(hw[i], b);
#pragma unroll
        for (int e = 0; e < 8; ++e) u[i][e] = a[e] * b[e]; }
#pragma unroll
    for (int i = 0; i < 4; ++i) {
        float bg[8]; unpack8(bw[i], bg); float o[8]; float ss = 0.f;
#pragma unroll
        for (int e = 0; e < 8; ++e) { o[e] = bg[e] * (w0[e] * u[i][e] + w1[e] * u[i + 1][e] + w2[e] * u[i + 2][e]); ss += o[e] * o[e]; }
        ss = wave_sum(ss);
        const float rstd = rsqrtf(ss * (1.0f / 512.0f) + EPS);
#pragma unroll
        for (int e = 0; e < 8; ++e) o[e] *= rstd;
        *(v4u*)(mixed + (row0 + i) * D + 512 + ch) = pack8(o);
        if (cp_out && t + i >= SEQ - 2) { float* uo = cp_out + (size_t)(t + i - (SEQ - 2)) * 512 + ch;
            *(f32x4*)uo = (f32x4){u[i + 2][0], u[i + 2][1], u[i + 2][2], u[i + 2][3]}; *(f32x4*)(uo + 4) = (f32x4){u[i + 2][4], u[i + 2][5], u[i + 2][6], u[i + 2][7]}; }
    }
}

struct MixP { const bf16* z; bf16* mixed; const float* rope; const float *gq, *gk, *sinks, *convw, *cache_k, *cache_v, *state_conv; float* out; };

__device__ __forceinline__ void mixer_prompt_unit(const MixP& P, LAS unsigned char* lds, int b, int jblk, int conv_nb  ) {
    const int tid = opaque_tid(), lane = tid & 63, w = __builtin_amdgcn_readfirstlane(tid >> 6), fr = lane & 15, fq = lane >> 4;
    const int t0 = 64 * jblk; const bf16* z = P.z;
    v4u qraw[4][2];
#pragma unroll
    for (int s = 0; s < 4; ++s) { const bf16* zq = z + (size_t)(b * SEQ + t0 + 16 * s + fr) * NIN + w * 64; qraw[s][0] = *(const v4u*)(zq + 8 * fq); qraw[s][1] = *(const v4u*)(zq + 32 + 8 * fq); }
#pragma unroll
    for (int p = 0; p < 6; ++p) {
        const int id = p * 512 + tid, rowid = id >> 3, j = id & 7, kvh = rowid >= KROWS ? 1 : 0, r = rowid - KROWS * kvh;
        const int t = t0 - 128 + r; const bool valid = t >= 0; const int tc = valid ? t : 0;
        const v4u wv = *(const v4u*)(z + (size_t)(b * SEQ + tc) * NIN + 512 + kvh * 64 + 8 * j);
        float x[8]; unpack8(wv, x);
        k_norm_rope(x, j, P.gk, P.rope + tc * 64);
        if (!valid) {
#pragma unroll
            for (int e = 0; e < 8; ++e) x[e] = 0.f; }
        *(LAS v4u*)(lds + MX_KS + ((kvh * KROWS + r) * KST + 8 * j) * 2) = pack8(x);
        if (r >= 128 && t >= SEQ - 128) { float* kp = P.out + OFF_KP + ((size_t)((b * 128 + (t - (SEQ - 128))) * 2 + kvh)) * 64 + 8 * j;
            __builtin_nontemporal_store((f32x4){x[0], x[1], x[2], x[3]}, (f32x4*)kp); __builtin_nontemporal_store((f32x4){x[4], x[5], x[6], x[7]}, (f32x4*)(kp + 4)); }
    }
    for (int p = 0; p < 2; ++p) {
        const int id = p * 512 + tid;
        if (id < 768) {
            const int dc = id & 7, kg = (id >> 3) % 48, kvh = id / 384; float v[4][8];
#pragma unroll
            for (int kk = 0; kk < 4; ++kk) { const int r = 4 * kg + kk, t = t0 - 128 + r;
                if (t >= 0) { const v4u wv = *(const v4u*)(z + (size_t)(b * SEQ + t) * NIN + 640 + kvh * 64 + 8 * dc); unpack8(wv, v[kk]); }
                else {
#pragma unroll
                    for (int e = 0; e < 8; ++e) v[kk][e] = 0.f; }
                if (r >= 128 && t >= SEQ - 128) { float* vp = P.out + OFF_VP + ((size_t)((b * 128 + (t - (SEQ - 128))) * 2 + kvh)) * 64 + 8 * dc;
                    __builtin_nontemporal_store((f32x4){v[kk][0], v[kk][1], v[kk][2], v[kk][3]}, (f32x4*)vp); __builtin_nontemporal_store((f32x4){v[kk][4], v[kk][5], v[kk][6], v[kk][7]}, (f32x4*)(vp + 4)); } }
#pragma unroll
            for (int e = 0; e < 8; ++e) { v2u o; o.x = pk2(v[0][e], v[1][e]); o.y = pk2(v[2][e], v[3][e]); *(LAS v2u*)(lds + MX_VT + ((kvh * 64 + 8 * dc + e) * VST + 4 * kg) * 2) = o; }
        }
    }
    __syncthreads();
    f32x4 O[4][4]; LAS float* red = (LAS float*)(lds + MX_RED);
    const int kvh = w >> 2; const float sink2 = P.sinks[w] * LOG2E;
#pragma unroll
    for (int s = 0; s < 4; ++s) {
        const int tq = t0 + 16 * s + fr; s16x8 q0, q1;
        q_frag_raw(qraw[s][0], qraw[s][1], P.gq, P.rope + tq * 64, fq, q0, q1);
        attn_strip((const LAS bf16*)(lds + MX_KS) + (kvh * KROWS + 16 * s) * KST, (const LAS bf16*)(lds + MX_VT) + kvh * 64 * VST + 16 * s, q0, q1, fr, 128 - t0 - 16 * s, sink2, fr, fq, O[s]);
        float q = 0.f;
#pragma unroll
        for (int dt = 0; dt < 4; ++dt) q += (O[s][dt][0] * O[s][dt][0] + O[s][dt][1] * O[s][dt][1]) + (O[s][dt][2] * O[s][dt][2] + O[s][dt][3] * O[s][dt][3]);
        q += __shfl_xor(q, 16); q += __shfl_xor(q, 32);
        if (fq == 0) red[(16 * s + fr) * 8 + w] = q;
        __builtin_amdgcn_sched_barrier(0);
    }
    __syncthreads();
#pragma unroll
    for (int s = 0; s < 4; ++s) {
        const LAS f32x4* rr = (const LAS f32x4*)(red + (16 * s + fr) * 8); const f32x4 a = rr[0], c = rr[1];
        const float rstd = rsqrtf(((a[0] + a[1]) + (a[2] + a[3]) + (c[0] + c[1]) + (c[2] + c[3])) * (1.0f / 512.0f) + EPS);
        bf16* mp = P.mixed + (size_t)(b * SEQ + t0 + 16 * s + fr) * D + w * 64 + 4 * fq;
#pragma unroll
        for (int dt = 0; dt < 4; ++dt) { v2u o; o.x = pk2(O[s][dt][0] * rstd, O[s][dt][1] * rstd); o.y = pk2(O[s][dt][2] * rstd, O[s][dt][3] * rstd); *(v2u*)(mp + 16 * dt) = o; }
    }
    for (int i = 0; i < conv_nb; ++i) {
        const int t = t0 + 4 * (8 * i + w);
        conv_tokens4(z, P.mixed, P.convw, (size_t)b * SEQ + t, t, (t + 4 > SEQ - 2) ? P.out + OFF_CP + (size_t)b * 2 * 512 : nullptr, lane);
    }
    __syncthreads();
}

__device__ __forceinline__ void mixer_conv_half(const MixP& P, int b, int jblk) {
    const int lane = threadIdx.x & 63, w = __builtin_amdgcn_readfirstlane((int)(threadIdx.x >> 6));
    const int t = 64 * jblk + 4 * (8 + w);
    conv_tokens4(P.z, P.mixed, P.convw, (size_t)b * SEQ + t, t, (t + 4 > SEQ - 2) ? P.out + OFF_CP + (size_t)b * 2 * 512 : nullptr, lane);
}
__device__ __forceinline__ void mixer_sample_unit(const MixP& P, LAS unsigned char* lds, int sq) {
    const int tid = opaque_tid(), lane = tid & 63, w = __builtin_amdgcn_readfirstlane(tid >> 6), fr = lane & 15, fq = lane >> 4;
    const bf16* z = P.z; const size_t zr0 = (size_t)MP + 4 * sq;
    {
        f32x4 ca[4][2];
#pragma unroll
        for (int p = 0; p < 4; ++p) { const int id = p * 512 + tid, rowid = id >> 3, j = id & 7, kvh = rowid >> 7, r = rowid & 127;
            const float* cp = P.cache_k + ((size_t)(sq * 128 + r) * 2 + kvh) * 64 + 8 * j; ca[p][0] = __builtin_nontemporal_load((const f32x4*)cp); ca[p][1] = __builtin_nontemporal_load((const f32x4*)(cp + 4)); }
#pragma unroll
        for (int p = 0; p < 4; ++p) { const int id = p * 512 + tid, rowid = id >> 3, j = id & 7, kvh = rowid >> 7, r = rowid & 127;
            v4u o; o.x = pk2(ca[p][0][0], ca[p][0][1]); o.y = pk2(ca[p][0][2], ca[p][0][3]); o.z = pk2(ca[p][1][0], ca[p][1][1]); o.w = pk2(ca[p][1][2], ca[p][1][3]);
            *(LAS v4u*)(lds + MX_KS + ((kvh * KROWS + r) * KST + 8 * j) * 2) = o;
            if (r >= 4) { float* kp = P.out + OFF_KS + ((size_t)(sq * 128 + (r - 4)) * 2 + kvh) * 64 + 8 * j; __builtin_nontemporal_store(ca[p][0], (f32x4*)kp); __builtin_nontemporal_store(ca[p][1], (f32x4*)(kp + 4)); } }
        if (w == 0) {
            const int rowid = lane >> 3, j = lane & 7, kvh = rowid >> 2, tn = rowid & 3;
            const v4u wv = *(const v4u*)(z + (zr0 + tn) * NIN + 512 + kvh * 64 + 8 * j);
            float x[8]; unpack8(wv, x);
            k_norm_rope(x, j, P.gk, P.rope + (2048 + tn) * 64);
            *(LAS v4u*)(lds + MX_KS + ((kvh * KROWS + 128 + tn) * KST + 8 * j) * 2) = pack8(x);
            float* kp = P.out + OFF_KS + ((size_t)(sq * 128 + 124 + tn) * 2 + kvh) * 64 + 8 * j;
            *(f32x4*)kp = (f32x4){x[0], x[1], x[2], x[3]}; *(f32x4*)(kp + 4) = (f32x4){x[4], x[5], x[6], x[7]};
        } else if (w == 1) {
#pragma unroll
            for (int p = 0; p < 3; ++p) { const int id = p * 64 + lane, rowid = id >> 3, j = id & 7, kvh = rowid / 12, r = 132 + rowid % 12;
                *(LAS v4u*)(lds + MX_KS + ((kvh * KROWS + r) * KST + 8 * j) * 2) = (v4u){0u, 0u, 0u, 0u}; }
        }
    }
    for (int p = 0; p < 2; ++p) {
        const int id = p * 512 + tid;
        if (id < 576) {
            const int dc = id & 7, kg = (id >> 3) % 36, kvh = id / 288; float v[4][8];
#pragma unroll
            for (int kk = 0; kk < 4; ++kk) { const int r = 4 * kg + kk;
                if (r < 128) { const float* cp = P.cache_v + ((size_t)(sq * 128 + r) * 2 + kvh) * 64 + 8 * dc; const f32x4 a = __builtin_nontemporal_load((const f32x4*)cp), c = __builtin_nontemporal_load((const f32x4*)(cp + 4));
                    v[kk][0] = a[0]; v[kk][1] = a[1]; v[kk][2] = a[2]; v[kk][3] = a[3]; v[kk][4] = c[0]; v[kk][5] = c[1]; v[kk][6] = c[2]; v[kk][7] = c[3]; }
                else if (r < 132) { const v4u wv = *(const v4u*)(z + (zr0 + (r - 128)) * NIN + 640 + kvh * 64 + 8 * dc); unpack8(wv, v[kk]); }
                else {
#pragma unroll
                    for (int e = 0; e < 8; ++e) v[kk][e] = 0.f; }
                if (r >= 4 && r < 132) { float* vp = P.out + OFF_VS + ((size_t)(sq * 128 + (r - 4)) * 2 + kvh) * 64 + 8 * dc;
                    __builtin_nontemporal_store((f32x4){v[kk][0], v[kk][1], v[kk][2], v[kk][3]}, (f32x4*)vp); __builtin_nontemporal_store((f32x4){v[kk][4], v[kk][5], v[kk][6], v[kk][7]}, (f32x4*)(vp + 4)); } }
#pragma unroll
            for (int e = 0; e < 8; ++e) { v2u o; o.x = pk2(v[0][e], v[1][e]); o.y = pk2(v[2][e], v[3][e]); *(LAS v2u*)(lds + MX_VT + ((kvh * 64 + 8 * dc + e) * VST + 4 * kg) * 2) = o; }
        }
    }
    __syncthreads();
    f32x4 O[4]; LAS float* red = (LAS float*)(lds + MX_RED);
    const int hh = fr >> 2, t = fr & 3, head = (w & 1) * 4 + hh;
    if (w < 2) {
        s16x8 q0, q1;
        q_frag(z + (zr0 + t) * NIN + head * 64, P.gq, P.rope + (2048 + t) * 64, fq, q0, q1);
        attn_strip((const LAS bf16*)(lds + MX_KS) + (w * KROWS) * KST, (const LAS bf16*)(lds + MX_VT) + w * 64 * VST, q0, q1, t, 0, P.sinks[head] * LOG2E, fr, fq, O);
        float q = 0.f;
#pragma unroll
        for (int dt = 0; dt < 4; ++dt) q += (O[dt][0] * O[dt][0] + O[dt][1] * O[dt][1]) + (O[dt][2] * O[dt][2] + O[dt][3] * O[dt][3]);
        q += __shfl_xor(q, 16); q += __shfl_xor(q, 32);
        if (fq == 0) red[t * 8 + head] = q;
    }
    __syncthreads();
    if (w < 2) {
        const LAS f32x4* rr = (const LAS f32x4*)(red + t * 8); const f32x4 a = rr[0], c = rr[1];
        const float rstd = rsqrtf(((a[0] + a[1]) + (a[2] + a[3]) + (c[0] + c[1]) + (c[2] + c[3])) * (1.0f / 512.0f) + EPS);
        bf16* mp = P.mixed + (zr0 + t) * D + head * 64 + 4 * fq;
#pragma unroll
        for (int dt = 0; dt < 4; ++dt) { v2u o; o.x = pk2(O[dt][0] * rstd, O[dt][1] * rstd); o.y = pk2(O[dt][2] * rstd, O[dt][3] * rstd); *(v2u*)(mp + 16 * dt) = o; }
    } else if (w < 6) {
        const int tt = w - 2; const size_t row = zr0 + tt; const float* st = P.state_conv + (size_t)sq * 2 * 512;
        float* uo = tt >= 2 ? P.out + OFF_CS + (size_t)(sq * 2 + (tt - 2)) * 512 : nullptr;
        conv_token(z, P.mixed, P.convw, row, tt >= 1 ? 1 : 2, row - 1, st + 512, tt >= 2 ? 1 : 2, row - 2, st + tt * 512, uo, lane);
    }
    __syncthreads();
}
template <int NA, int NBT, int KSB> struct MiniBatch { s16x8 a[KSB][NA], b[KSB][NBT]; };
template <int NA, int NBT, int KSB>
__device__ __forceinline__ void mb_load(MiniBatch<NA, NBT, KSB>& m, const bf16* ap, const bf16* bp, size_t lda16, size_t ldb16, int k0, int fq) {
#pragma unroll
    for (int s = 0; s < KSB; ++s) {
        const int ko = (KSB >= 2) ? k0 + 64 * (s >> 1) + 16 * fq + 8 * (s & 1) : k0 + 8 * fq;
#pragma unroll
        for (int mt = 0; mt < NA; ++mt) m.a[s][mt] = *(const s16x8*)(ap + mt * lda16 + ko);
#pragma unroll
        for (int nt = 0; nt < NBT; ++nt) m.b[s][nt] = *(const s16x8*)(bp + nt * ldb16 + ko);
    }
}
template <int NA, int NBT, int KSB>
__device__ __forceinline__ void mb_mma(f32x4 (&acc)[NA][NBT], const MiniBatch<NA, NBT, KSB>& m) {
#pragma unroll
    for (int s = 0; s < KSB; ++s)
#pragma unroll
        for (int mt = 0; mt < NA; ++mt)
#pragma unroll
            for (int nt = 0; nt < NBT; ++nt) acc[mt][nt] = __builtin_amdgcn_mfma_f32_16x16x32_bf16(m.b[s][nt], m.a[s][mt], acc[mt][nt], 0, 0, 0);
}
template <int NA, int NBT, int KSB, int NBATCH>
__device__ __forceinline__ void mb_run(f32x4 (&acc)[NA][NBT], const bf16* ap, const bf16* bp, size_t lda16, size_t ldb16, int fq) {
    MiniBatch<NA, NBT, KSB> buf[2];
#pragma unroll
    for (int i = 0; i < 2; ++i) if (i < NBATCH) mb_load(buf[i], ap, bp, lda16, ldb16, i * KSB * 32, fq);
    __builtin_amdgcn_sched_barrier(0);
#pragma unroll
    for (int i = 0; i < NBATCH; ++i) {
        mb_mma(acc, buf[i % 2]);
        __builtin_amdgcn_sched_barrier(0);
        if (i + 2 < NBATCH) { mb_load(buf[i % 2], ap, bp, lda16, ldb16, (i + 2) * KSB * 32, fq); __builtin_amdgcn_sched_barrier(0); }
    }
}
struct MiniEpi { bf16* O; int ldo; const float* rs; const float* ssp; const float* base; float* out; float* sspo; const bf16* pp; };
constexpr int MINI_RED2 = 65536;
template <int MODE, int K>
__device__ __forceinline__ void mini_tile(LAS unsigned char* lds, const bf16* A, const bf16* Bt, int r0, int c0, const MiniEpi& E) {
    const int tid = opaque_tid(), lane = tid & 63, w = __builtin_amdgcn_readfirstlane(tid >> 6), fr = lane & 15, fq = lane >> 4;
    constexpr int ks = K >> 3;
    const bf16* ap = A + (size_t)(r0 + fr) * K + w * ks;
    const bf16* bp = Bt + (size_t)(c0 + fr) * K + w * ks;
    f32x4 acc[2][4];
#pragma unroll
    for (int mt = 0; mt < 2; ++mt)
#pragma unroll
        for (int nt = 0; nt < 4; ++nt) acc[mt][nt] = (f32x4){0.f, 0.f, 0.f, 0.f};
    if constexpr (ks >= 64) mb_run<2, 4, 2, ks / 64>(acc, ap, bp, (size_t)16 * K, (size_t)16 * K, fq);
    else mb_run<2, 4, 1, 1>(acc, ap, bp, (size_t)16 * K, (size_t)16 * K, fq);
    LAS f32x4* red = (LAS f32x4*)lds;
#pragma unroll
    for (int mt = 0; mt < 2; ++mt)
#pragma unroll
        for (int nt = 0; nt < 4; ++nt) red[w * 512 + (mt * 4 + nt) * 64 + lane] = acc[mt][nt];
    __syncthreads();
    f32x4 v = red[tid];
#pragma unroll
    for (int ww = 1; ww < 8; ++ww) v += red[ww * 512 + tid];
    const int mt = tid >> 8, nt = (tid >> 6) & 3, rl = 16 * mt + fr, row = r0 + rl, col = c0 + 16 * nt + 4 * fq; const size_t R = (size_t)MP + row;
    if constexpr (MODE == 0) {
        const float sc = E.rs ? E.rs[R] : 1.0f; v2u o; o.x = pk2(v[0] * sc, v[1] * sc); o.y = pk2(v[2] * sc, v[3] * sc); *(v2u*)(E.O + R * E.ldo + col) = o;
    } else if constexpr (MODE == 1) {
        const float sc = pg8::rstd_from_ssp(E.ssp, (int)R); float t[4];
#pragma unroll
        for (int e = 0; e < 4; ++e) { const float x = fmaxf(v[e] * sc, 0.f); t[e] = x * x; }
        v2u o; o.x = pk2(t[0], t[1]); o.y = pk2(t[2], t[3]); *(v2u*)(E.O + R * E.ldo + col) = o;
    } else if constexpr (MODE == 2 || MODE == 4) {
        if constexpr (MODE == 2) { const f32x4 b = *(const f32x4*)(E.base + (size_t)row * 1024 + col); v += b; }
        else { const v2u bw = *(const v2u*)(E.pp + R * 1024 + col); v += (f32x4){bflo(bw.x), bfhi(bw.x), bflo(bw.y), bfhi(bw.y)}; }
        v2u o; o.x = pk2(v[0], v[1]); o.y = pk2(v[2], v[3]); *(v2u*)(E.O + R * 1024 + col) = o;
        LAS float* red2 = (LAS float*)(lds + MINI_RED2);
        red2[rl * 16 + nt * 4 + fq] = (v[0] * v[0] + v[1] * v[1]) + (v[2] * v[2] + v[3] * v[3]);
        __syncthreads();
        if (tid < 32) { const LAS f32x4* p = (const LAS f32x4*)(red2 + tid * 16); const f32x4 s = (p[0] + p[1]) + (p[2] + p[3]); E.sspo[((size_t)MP + r0 + tid) * 16 + (c0 >> 6)] = (s[0] + s[1]) + (s[2] + s[3]); }
    } else {
        const float sc = pg8::rstd_from_ssp(E.ssp, (int)R); const v2u xw = *(const v2u*)(E.O + R * 1024 + col); const v2u pw = *(const v2u*)(E.pp + R * 1024 + col);
        const float xv[4] = {bflo(xw.x), bfhi(xw.x), bflo(xw.y), bfhi(xw.y)}; const float pv[4] = {bflo(pw.x), bfhi(pw.x), bflo(pw.y), bfhi(pw.y)}; f32x4 y;
#pragma unroll
        for (int e = 0; e < 4; ++e) y[e] = xv[e] + pv[e] / (1.0f + __expf(-v[e] * sc));
        *(f32x4*)(E.out + R * 1024 + col) = y;
    }
    __syncthreads();
}
template <int MODE, int K>
__device__ __forceinline__ void mini_gemm(LAS unsigned char* lds, const bf16* A, const bf16* Bt, int N, const MiniEpi& E, int G) {
    const int ncb = N >> 6, nt = 16 * ncb;
    for (int t = blockIdx.x; t < nt; t += G) mini_tile<MODE, K>(lds, A, Bt, 32 * (t / ncb), 64 * (t % ncb), E);
}

__device__ __forceinline__ void mini_up(LAS unsigned char* lds, const bf16* A, const bf16* Bt, const float* ssp, bf16* U, int G) {
    const int tid_ = opaque_tid(); const int lane = tid_ & 63, w = __builtin_amdgcn_readfirstlane(tid_ >> 6), fr = lane & 15, fq = lane >> 4;
    for (int t = blockIdx.x; t < 256; t += G) {
        const int r0 = 32 * (t >> 4), c0 = 256 * (t & 15) + 32 * w;
        {
            s16x8 av[8];
#pragma unroll
            for (int i = 0; i < 8; ++i) { const int pc = 8 * w + i, mt = pc >> 5, ksx = pc & 31; av[i] = *(const s16x8*)(A + (size_t)(r0 + 16 * mt + fr) * D + 64 * (ksx >> 1) + 16 * fq + 8 * (ksx & 1)); }
#pragma unroll
            for (int i = 0; i < 8; ++i) *(LAS s16x8*)(lds + (8 * w + i) * 1024 + lane * 16) = av[i];
        }
        __syncthreads();
        const bf16* bp = Bt + (size_t)(c0 + fr) * D;
        f32x4 acc[2][2];
#pragma unroll
        for (int mt = 0; mt < 2; ++mt)
#pragma unroll
            for (int nt = 0; nt < 2; ++nt) acc[mt][nt] = (f32x4){0.f, 0.f, 0.f, 0.f};
        s16x8 bb[2][4][2];
#define MU_LOAD(buf, b) do { _Pragma("unroll") for (int s_ = 0; s_ < 4; ++s_) { const int ko = 128 * (b) + 64 * (s_ >> 1) + 16 * fq + 8 * (s_ & 1); \
            _Pragma("unroll") for (int nt = 0; nt < 2; ++nt) bb[buf][s_][nt] = *(const s16x8*)(bp + (size_t)nt * 16 * D + ko); } } while (0)
#define MU_MMA(buf, b) do { _Pragma("unroll") for (int s_ = 0; s_ < 4; ++s_) { const int ksx = 4 * (b) + s_; \
            const s16x8 a0 = *(const LAS s16x8*)(lds + ksx * 1024 + lane * 16), a1 = *(const LAS s16x8*)(lds + (32 + ksx) * 1024 + lane * 16); \
            _Pragma("unroll") for (int nt = 0; nt < 2; ++nt) { acc[0][nt] = __builtin_amdgcn_mfma_f32_16x16x32_bf16(bb[buf][s_][nt], a0, acc[0][nt], 0, 0, 0); acc[1][nt] = __builtin_amdgcn_mfma_f32_16x16x32_bf16(bb[buf][s_][nt], a1, acc[1][nt], 0, 0, 0); } } } while (0)
        MU_LOAD(0, 0); MU_LOAD(1, 1);
        MU_MMA(0, 0); MU_LOAD(0, 2); MU_MMA(1, 1); MU_LOAD(1, 3); MU_MMA(0, 2); MU_LOAD(0, 4); MU_MMA(1, 3); MU_LOAD(1, 5);
        MU_MMA(0, 4); MU_LOAD(0, 6); MU_MMA(1, 5); MU_LOAD(1, 7); MU_MMA(0, 6); MU_MMA(1, 7);
#undef MU_LOAD
#undef MU_MMA
#pragma unroll
        for (int mt = 0; mt < 2; ++mt) { const size_t R = (size_t)MP + r0 + 16 * mt + fr; const float sc = pg8::rstd_from_ssp(ssp, (int)R);
#pragma unroll
            for (int nt = 0; nt < 2; ++nt) { float tv[4];
#pragma unroll
                for (int e = 0; e < 4; ++e) { const float x = fmaxf(acc[mt][nt][e] * sc, 0.f); tv[e] = x * x; }
                v2u o; o.x = pk2(tv[0], tv[1]); o.y = pk2(tv[2], tv[3]); *(v2u*)(U + R * FF + c0 + 16 * nt + 4 * fq) = o; } }
        __syncthreads();
    }
}

constexpr int WS_SCNT_WORD = 3584;
struct P1Order {
    pg8::StaticOrder S; int c; unsigned* cnt;
    __device__ bool next(int i, pg8::Unit& u) const {
        if (c >= 64 && c < 82) { if (i == 0) { u.pm = 64 + (c - 64) / 9; u.pn = (c - 64) % 9; return true; } return S.next(i - 1, u); }
        return S.next(i, u);
    }
    __device__ __forceinline__ void a_ready(const pg8::Unit&) const {}
    __device__ __forceinline__ void done(const pg8::Unit& u) const {
        if (u.pm >= 64) {
            asm volatile("s_waitcnt vmcnt(0)" ::: "memory");
            __builtin_amdgcn_fence(__ATOMIC_RELEASE, "agent");
            asm volatile("s_waitcnt vmcnt(0)" ::: "memory");
            if ((threadIdx.x & 63) == 0) __hip_atomic_fetch_add(cnt, 1u, __ATOMIC_RELAXED, __HIP_MEMORY_SCOPE_AGENT);
        }
    }
};

#define XB_TMO      128
#define XB_XCNT(j)  (256  + 64 * (j))
#define XB_XSUB(j)  (1280 + 64 * (j))
#define XB_XGEN(j)  (2304 + 64 * (j))
#define XB_TOP      3328
#define XB_TOPGEN   3392
#define XCD_BAR_WORDS 3456
#define XB_SPIN_CAP (1u << 18)

__device__ __forceinline__ unsigned xb_ld(unsigned* p)              { return __hip_atomic_load(p, __ATOMIC_RELAXED, __HIP_MEMORY_SCOPE_AGENT); }
__device__ __forceinline__ unsigned xb_add(unsigned* p, unsigned v) { return __hip_atomic_fetch_add(p, v, __ATOMIC_RELAXED, __HIP_MEMORY_SCOPE_AGENT); }
__device__ __forceinline__ unsigned xb_xcc_id() { return (unsigned)__builtin_amdgcn_s_getreg((3 << 11) | 20) & 0xFu; }
#define XB_SPIN(cond, bar) do { unsigned _sp = 0; while (cond) { __builtin_amdgcn_s_sleep(1); \
    if ((++_sp & 255u) == 0u) { if (xb_ld(&(bar)[XB_TMO])) break; if (_sp > XB_SPIN_CAP) { atomicAdd(&(bar)[XB_TMO], 1u); break; } } } } while (0)

struct XcdBarrier {
    unsigned* bar; unsigned x;
    volatile LAS unsigned* st;
};

__device__ __forceinline__ XcdBarrier xcd_barrier_post(unsigned* bar, volatile LAS unsigned* st) {
    XcdBarrier b; b.bar = bar; b.x = xb_xcc_id(); b.st = st;
    if (threadIdx.x == 0) (void)xb_add(&bar[XB_XCNT(b.x)], 1u);
    return b;
}
__device__ __forceinline__ void xcd_barrier_complete(unsigned* bar, unsigned x, unsigned& nloc, unsigned& nx) {
    const unsigned G = gridDim.x * gridDim.y * gridDim.z;
    unsigned sum, cnt, mine, sp = 0u;
    for (;;) {
        sum = 0u; cnt = 0u; mine = 0u;
#pragma unroll
        for (unsigned j = 0; j < 16; ++j) { const unsigned c = xb_ld(&bar[XB_XCNT(j)]); sum += c; cnt += (c > 0u) ? 1u : 0u; mine = (j == x) ? c : mine; }
        if (sum == G) break;
        __builtin_amdgcn_s_sleep(1);
        if ((++sp & 255u) == 0u) { if (xb_ld(&bar[XB_TMO])) break; if (sp > XB_SPIN_CAP) { atomicAdd(&bar[XB_TMO], 1u); break; } }
    }
    nloc = mine > 0u ? mine : 1u; nx = cnt > 0u ? cnt : 1u;
}

__device__ __forceinline__ void xcd_barrier(const XcdBarrier& b) {
    asm volatile("s_waitcnt vmcnt(0)" ::: "memory");
    __syncthreads();
    if (threadIdx.x == 0) {
        unsigned* bar = b.bar;
        __builtin_amdgcn_s_waitcnt(0);
        unsigned nloc = b.st[0], nx = b.st[1];
        if (nloc == 0u) { xcd_barrier_complete(bar, b.x, nloc, nx); b.st[0] = nloc; b.st[1] = nx; }
        const unsigned old = xb_add(&bar[XB_XSUB(b.x)], 1u);
        const unsigned gen = old / nloc;
        if (old + 1u == (gen + 1u) * nloc) {
            __builtin_amdgcn_fence(__ATOMIC_RELEASE, "agent");
            asm volatile("s_waitcnt vmcnt(0)" ::: "memory");
            const unsigned og = xb_add(&bar[XB_TOP], 1u);
            const unsigned tg = og / nx;
            if (og + 1u == (tg + 1u) * nx) xb_add(&bar[XB_TOPGEN], 1u);
            else XB_SPIN(xb_ld(&bar[XB_TOPGEN]) == tg, bar);
            __builtin_amdgcn_fence(__ATOMIC_ACQUIRE, "agent");
            xb_add(&bar[XB_XGEN(b.x)], 1u);
            asm volatile("s_waitcnt vmcnt(0)" ::: "memory");
        } else {
            XB_SPIN(xb_ld(&bar[XB_XGEN(b.x)]) == gen, bar);
            __builtin_amdgcn_fence(__ATOMIC_ACQUIRE, "agent");
            asm volatile("s_waitcnt vmcnt(0)" ::: "memory");
        }
    }
    __syncthreads();
}

#ifndef COOP
#define COOP 1
#endif
constexpr int N_PHASES = 7;
#ifndef DUP_PHASE
#define DUP_PHASE -1
#endif
#ifndef EXTRA_SYNCS
#define EXTRA_SYNCS 0
#endif
#define REPS(k) for (int rep_ = 0; rep_ < ((DUP_PHASE == (k)) ? 2 : 1); ++rep_)
#define DUPSYNC(k) do { if (DUP_PHASE == (k) && rep_ == 0) xcd_barrier(bar); } while (0)

__global__ void __launch_bounds__(NWAVES * 64, 2) fwd_megakernel(Args a) {
    extern __shared__ __attribute__((aligned(16))) unsigned char lds_raw[];
    LAS unsigned char* lds = (LAS unsigned char*)lds_raw;
    const int G = gridDim.x, lo = a.ph_lo, hi = a.ph_hi;
    unsigned char* ws = a.ws;
    volatile LAS unsigned* MISC = (volatile LAS unsigned*)(lds + 131072);
    if (threadIdx.x < 64) MISC[threadIdx.x] = 0u;
    __syncthreads();
    XcdBarrier bar = xcd_barrier_post((unsigned*)(ws + WS_BAR), MISC + 8);
    bf16 *WIN = (bf16*)(ws + WS_WIN), *WO = (bf16*)(ws + WS_WO), *WUP = (bf16*)(ws + WS_WUP), *WDN = (bf16*)(ws + WS_WDN), *WG = (bf16*)(ws + WS_WG), *WP = (bf16*)(ws + WS_WP);
    bf16 *XB = (bf16*)(ws + WS_XB), *PB = (bf16*)(ws + WS_PB), *Z = (bf16*)(ws + WS_Z), *MIXED = (bf16*)(ws + WS_MIXED), *X1B = (bf16*)(ws + WS_X1B), *U = (bf16*)(ws + WS_U), *X2B = (bf16*)(ws + WS_X2B), *PPB = (bf16*)(ws + WS_PPB);
    float *RSTD0 = (float*)(ws + WS_RSTD0), *ROPE = (float*)(ws + WS_ROPE), *SS1 = (float*)(ws + WS_SS1), *SS2 = (float*)(ws + WS_SS2);
#ifndef PH_MASK
#define PH_MASK 0x7f
#endif
#define IN(k) (((PH_MASK >> (k)) & 1) && lo <= (k) && (k) < hi)
#if COOP
#define SEAM(k) do { if (IN(k) && IN((k) + 1)) xcd_barrier(bar); } while (0)
#else
#define SEAM(k) do { } while (0)
#endif
    typedef pg8::StaticOrder SO;
    if (hi > 1000) cg::this_grid().sync();
    for (int i_ = 0; i_ < EXTRA_SYNCS; ++i_) xcd_barrier(bar);
    if (IN(0)) REPS(0) { p0_prologue(a, lds, G); __syncthreads(); DUPSYNC(0); }
    SEAM(0);
    if (IN(1)) REPS(1) {
        unsigned* scnt = (unsigned*)(ws + WS_BAR) + WS_SCNT_WORD;
        pg8::Gemm g{XB, WIN, M, NIN, D}; P1Order S; S.S.init(MP, NIN, G, (int)blockIdx.x); S.c = (G == 256) ? (int)blockIdx.x : -1; S.cnt = scnt;
        pg8::Epi<0> E{Z, NIN, RSTD0, nullptr, nullptr, nullptr, nullptr, nullptr, nullptr};
        if (G == 256) pg8::gemm_phase<pg8::Epi<0>, P1Order, true, true>(lds, g, S, E);
        if ((int)blockIdx.x >= P1_LIGHT0) {
            const int c = (int)blockIdx.x, wv = __builtin_amdgcn_readfirstlane((int)(threadIdx.x >> 6));
            if (c < P1_LIGHT0 + 128) p0_weights(a, lds, 1, (c - P1_LIGHT0) * NWAVES + wv, 128 * NWAVES, 2048);
            else p0_weights(a, lds, 1, 2048 + (c - P1_LIGHT0 - 128) * NWAVES + wv, (G - P1_LIGHT0 - 128) * NWAVES);
        }
        if (G == 256 && (int)blockIdx.x >= P1_LIGHT0) {
            if (threadIdx.x == 0) { unsigned sp = 0; while (__hip_atomic_load(scnt, __ATOMIC_RELAXED, __HIP_MEMORY_SCOPE_AGENT) < 144u) { __builtin_amdgcn_s_sleep(8); if (++sp > (1u << 22)) break; }
                __builtin_amdgcn_fence(__ATOMIC_ACQUIRE, "agent"); asm volatile("s_waitcnt vmcnt(0)" ::: "memory"); }
            __syncthreads();
            MixP P{Z, MIXED, ROPE, a.in[9], a.in[10], a.in[11], a.in[12], a.in[4], a.in[5], a.in[6], a.out};
            for (int u = (int)blockIdx.x - P1_LIGHT0; u < 128; u += G - P1_LIGHT0) mixer_sample_unit(P, lds, u);
        }
        DUPSYNC(1);
    }
    SEAM(1);
    if (IN(2)) REPS(2) {
        MixP P{Z, MIXED, ROPE, a.in[9], a.in[10], a.in[11], a.in[12], a.in[4], a.in[5], a.in[6], a.out};
        for (int u = blockIdx.x; u < 256; u += G) mixer_prompt_unit(P, lds, u & 7, u >> 3, 2);
        DUPSYNC(2);
    }
    SEAM(2);
    if (IN(3)) REPS(3) {
        pg8::Gemm g{MIXED, WO, MP, D, D}; SO S; S.init(MP, D, G, (int)blockIdx.x);
        pg8::Epi<4> E{X1B, D, nullptr, nullptr, nullptr, nullptr, nullptr, SS1, XB};
        pg8::gemm_phase<pg8::Epi<4>, SO, true, true>(lds, g, S, E);
        MiniEpi ME{X1B, D, nullptr, nullptr, nullptr, nullptr, SS1, XB};
        mini_gemm<4, D>(lds, MIXED + (size_t)MP * D, WO, D, ME, G); DUPSYNC(3);
    }
    SEAM(3);
    if (IN(4)) REPS(4) {
        pg8::Gemm g{X1B, WUP, MP, FF, D}; SO S; S.init(MP, FF, G, (int)blockIdx.x);
        pg8::Epi<1> E{U, FF, nullptr, SS1, nullptr, nullptr, nullptr, nullptr, nullptr};
        pg8::gemm_phase<pg8::Epi<1>, SO, true, true>(lds, g, S, E);
        mini_up(lds, X1B + (size_t)MP * D, WUP, SS1, U, G); DUPSYNC(4);
    }
    SEAM(4);
    if (IN(5)) REPS(5) {
        pg8::Gemm g{U, WDN, MP, D, FF}; SO S; S.init(MP, D, G, (int)blockIdx.x);
        pg8::Epi<4> E{X2B, D, nullptr, nullptr, nullptr, nullptr, nullptr, SS2, X1B};
        pg8::gemm_phase<pg8::Epi<4>, SO, true, true>(lds, g, S, E);
        { MiniEpi ME{X2B, D, nullptr, nullptr, nullptr, nullptr, SS2, X1B};
            mini_gemm<4, FF>(lds, U + (size_t)MP * FF, WDN, D, ME, G); }
        DUPSYNC(5);
    }
    SEAM(5);
    if (IN(6) && DUP_PHASE == 6) { pg8::Gemm g{X2B, WG, MP, D, D}; SO S; S.init(MP, D, G, (int)blockIdx.x);
          pg8::Epi<0> E{X1B, D, nullptr, nullptr, nullptr, nullptr, nullptr, nullptr, nullptr};
          pg8::gemm_phase<pg8::Epi<0>, SO, true, true>(lds, g, S, E); xcd_barrier(bar); }
    if (IN(6)) {
        { pg8::Gemm g{PB, WP, MP, D, PLE}; SO S; S.init(MP, D, G, (int)blockIdx.x);
          pg8::Epi<0> E{PPB, D, nullptr, nullptr, nullptr, nullptr, nullptr, nullptr, nullptr};
          pg8::gemm_phase<pg8::Epi<0>, SO, true, true>(lds, g, S, E); }
        { pg8::Gemm g{X2B, WG, MP, D, D}; SO S; S.init(MP, D, G, (int)blockIdx.x);
          pg8::Epi<3> E{X2B, D, nullptr, SS2, nullptr, nullptr, a.out, nullptr, PPB};
          pg8::gemm_phase<pg8::Epi<3>, SO, true, true>(lds, g, S, E); }
        { MiniEpi ME0{PPB, D, nullptr, nullptr, nullptr, nullptr, nullptr, nullptr}; mini_gemm<0, PLE>(lds, PB + (size_t)MP * PLE, WP, D, ME0, G);
          MiniEpi ME3{X2B, D, nullptr, SS2, nullptr, a.out, nullptr, PPB}; mini_gemm<3, D>(lds, X2B + (size_t)MP * D, WG, D, ME3, G); }
    }
#undef IN
#undef SEAM
}

extern "C" void kernel_launch(void* const* d_in, const int* in_sizes, int n_in, void* d_out, int out_size, void* d_ws, size_t ws_size, hipStream_t stream) {
    static int grid = 0;
    if (grid == 0) {
        if (n_in != 22 || in_sizes[0] != MP * D || out_size != (int)OUT_TOTAL || ws_size < WS_END) {
            fprintf(stderr, "kernel_launch: unexpected shapes: n_in %d in0 %d out %d ws %zu (need out %zu ws %zu)\n", n_in, n_in > 0 ? in_sizes[0] : -1, out_size, ws_size, (size_t)OUT_TOTAL, (size_t)WS_END); grid = -1; return; }
        int dev = 0, cus = 0, per_cu = 0;
        hipGetDevice(&dev); hipDeviceGetAttribute(&cus, hipDeviceAttributeMultiprocessorCount, dev);
        if (hipFuncSetAttribute((const void*)fwd_megakernel, hipFuncAttributeMaxDynamicSharedMemorySize, LDS_BYTES) != hipSuccess) { fprintf(stderr, "kernel_launch: hipFuncSetAttribute failed\n"); grid = -1; return; }
        if (hipOccupancyMaxActiveBlocksPerMultiprocessor(&per_cu, (const void*)fwd_megakernel, NWAVES * 64, LDS_BYTES) != hipSuccess || per_cu < 1) { fprintf(stderr, "kernel_launch: occupancy query says %d\n", per_cu); per_cu = 1; }
        (void)hipGetLastError();
        grid = cus;
        if (grid != 256) { fprintf(stderr, "kernel_launch: this build's phase program is laid out for 256 CUs (got %d); nothing launched\n", cus); grid = -1; return; }
        fprintf(stderr, "kernel_launch: cus %d per_cu %d grid %d\n", cus, per_cu, grid);
    }
    if (grid < 0) return;
    Args a{};
    for (int i = 0; i < 22; ++i) a.in[i] = (const float*)d_in[i];
    a.out = (float*)d_out; a.ws = (unsigned char*)d_ws;
#if COOP
    if (hipMemsetAsync((char*)d_ws + WS_BAR, 0, WS_BAR_BYTES, stream) != hipSuccess) { fprintf(stderr, "kernel_launch: memset failed\n"); return; }
    a.ph_lo = 0; a.ph_hi = N_PHASES;
    void* args[] = {&a};
    hipError_t e = hipLaunchCooperativeKernel((const void*)fwd_megakernel, dim3(grid), dim3(NWAVES * 64), args, LDS_BYTES, stream);
    if (e != hipSuccess) fprintf(stderr, "kernel_launch: cooperative launch failed: %s (grid %d)\n", hipGetErrorString(e), grid);
#else
    for (int p = 0; p < N_PHASES; ++p) { a.ph_lo = p; a.ph_hi = p + 1; hipLaunchKernelGGL(fwd_megakernel, dim3(grid), dim3(NWAVES * 64), LDS_BYTES, stream, a); }
#endif
}
```
